# Optimizing an MI355X kernel written in HIP

```python
import math
import jax
import jax.numpy as jnp
from jax import lax
import numpy as np

D_MODEL = 1024
BATCH = 1
SEQ = 16384
DEPTH = 2
DEC_BATCH = 32
DEC_SEQ = 1
PAST_LEN = 16384
PAGE_SIZE = 128

N_A_LAYERS = DEPTH // 2
N_B_LAYERS = DEPTH - N_A_LAYERS

A_HEAD_DIM = 128
A_HEADS = D_MODEL // A_HEAD_DIM
A_WIDTH = A_HEADS * A_HEAD_DIM
A_CONV = 4
CHUNK = 64
A_PROJ = 3 * A_WIDTH + 2 * A_HEADS + A_WIDTH

HEAD_DIM = 128
GROUPS = ((128, 1), (512, 4), (2048, 16))
N_GROUPS = len(GROUPS)
Q_PER_GROUP = 4
KV_PER_GROUP = 2
Q_REP = Q_PER_GROUP // KV_PER_GROUP
N_Q_HEADS = N_GROUPS * Q_PER_GROUP
N_KV_HEADS = N_GROUPS * KV_PER_GROUP
ROPE_DIM = HEAD_DIM // 4
ROPE_THETA = 500000.0

D_FF = 2816
FFN_CONV = 3
PLE_DIM = 256
EPS = 1e-6
F32 = jnp.float32

kernel_name = 'yoco_gated_deltanet_dilated_window_step'


def rmsnorm(x, gain):
    xf = x.astype(F32)
    y = xf * lax.rsqrt(jnp.mean(xf * xf, axis=-1, keepdims=True) + EPS)
    return (y * gain.astype(F32)).astype(x.dtype)


def l2norm(x):
    return x * lax.rsqrt(jnp.sum(x * x, axis=-1, keepdims=True) + EPS)


def partial_rope(x, pos):
    half = ROPE_DIM // 2
    inv_freq = ROPE_THETA ** (-jnp.arange(half, dtype=F32) * 2.0 / ROPE_DIM)
    ang = pos.astype(F32)[:, None] * inv_freq[None, :]
    shape = (1, pos.shape[0]) + (1,) * (x.ndim - 3) + (half,)
    cos = jnp.cos(ang).reshape(shape)
    sin = jnp.sin(ang).reshape(shape)
    xr = x[..., :ROPE_DIM].astype(F32)
    x1, x2 = xr[..., :half], xr[..., half:]
    rot = jnp.concatenate([x1 * cos - x2 * sin, x2 * cos + x1 * sin], axis=-1).astype(x.dtype)
    return jnp.concatenate([rot, x[..., ROPE_DIM:]], axis=-1)


def causal_dwconv(x, buf, w):
    width, t = w.shape[0], x.shape[1]
    xp = jnp.concatenate([buf.astype(x.dtype), x], axis=1)
    y = xp[:, 0:t] * w[0]
    for j in range(1, width):
        y = y + xp[:, j:j + t] * w[j]
    return y, xp[:, t:]


def gated_delta_chunked(q, k, v, beta, g, s0):
    b, t, h, _ = q.shape
    dv = v.shape[-1]
    nc = t // CHUNK

    def to_chunks(a):
        a = a.reshape((b, nc, CHUNK, h) + a.shape[3:])
        return jnp.moveaxis(a, 3, 2)

    q, k, v, beta, g = (to_chunks(a) for a in (q, k, v, beta, g))
    gc = jnp.cumsum(g, axis=-1)
    idx = jnp.arange(CHUNK)
    incl = idx[:, None] >= idx[None, :]
    strict = idx[:, None] > idx[None, :]
    decay = jnp.exp(jnp.where(incl, gc[..., :, None] - gc[..., None, :], -jnp.inf))
    kk = jnp.einsum('bnhic,bnhjc->bnhij', k, k)
    tri = jnp.eye(CHUNK, dtype=F32) + jnp.where(strict, beta[..., :, None] * kk * decay, 0.0)
    gam = jnp.exp(gc)
    rhs = jnp.concatenate([v * beta[..., None], k * (beta * gam)[..., None]], axis=-1)
    sol = lax.linalg.triangular_solve(tri, rhs, left_side=True, lower=True, unit_diagonal=True)
    u0, wk = sol[..., :dv], sol[..., dv:]
    qk = jnp.einsum('bnhic,bnhjc->bnhij', q, k) * decay
    qg = q * gam[..., None]
    kd = k * jnp.exp(gc[..., -1:] - gc)[..., None]
    gend = jnp.exp(gc[..., -1])

    def step(s, xs):
        u0c, wkc, qkc, qgc, kdc, gec = xs
        u = u0c - jnp.einsum('bhck,bhkv->bhcv', wkc, s)
        o = jnp.einsum('bhck,bhkv->bhcv', qgc, s) + jnp.einsum('bhij,bhjv->bhiv', qkc, u)
        s = gec[..., None, None] * s + jnp.einsum('bhck,bhcv->bhkv', kdc, u)
        return s, o

    xs = tuple(jnp.moveaxis(a, 1, 0) for a in (u0, wk, qk, qg, kd, gend))
    s1, o = lax.scan(step, s0, xs)
    o = jnp.moveaxis(jnp.moveaxis(o, 0, 1), 2, 3).reshape(b, t, h, dv)
    return o, s1


def gated_delta_steps(q, k, v, beta, g, s0):
    def step(s, xs):
        qt, kt, vt, bt, gt = xs
        s = jnp.exp(gt)[..., None, None] * s
        u = bt[..., None] * (vt - jnp.einsum('bhk,bhkv->bhv', kt, s))
        s = s + kt[..., :, None] * u[..., None, :]
        return s, jnp.einsum('bhk,bhkv->bhv', qt, s)

    xs = tuple(jnp.moveaxis(a, 1, 0) for a in (q, k, v, beta, g))
    s1, o = lax.scan(step, s0, xs)
    return jnp.moveaxis(o, 0, 1), s1


def deltanet_mixer(hn, qkv_buf, s0, w_in, w_conv, a_log, dt_bias, g_out, w_out, chunked):
    b, t, _ = hn.shape
    proj = hn @ w_in
    o1, o2 = 3 * A_WIDTH, 3 * A_WIDTH + A_HEADS
    qkv, qkv_buf = causal_dwconv(proj[..., :o1], qkv_buf, w_conv)
    qkv = jax.nn.silu(qkv.astype(F32)).reshape(b, t, 3, A_HEADS, A_HEAD_DIM)
    q = l2norm(qkv[:, :, 0]) * (A_HEAD_DIM ** -0.5)
    k = l2norm(qkv[:, :, 1])
    v = qkv[:, :, 2]
    a = proj[..., o1:o2].astype(F32)
    beta = jax.nn.sigmoid(proj[..., o2:o2 + A_HEADS].astype(F32))
    z = proj[..., o2 + A_HEADS:].reshape(b, t, A_HEADS, A_HEAD_DIM).astype(F32)
    g = -jnp.exp(a_log.astype(F32)) * jax.nn.softplus(a + dt_bias.astype(F32))
    s0 = s0.astype(F32)
    if chunked:
        o, s1 = gated_delta_chunked(q, k, v, beta, g, s0)
    else:
        o, s1 = gated_delta_steps(q, k, v, beta, g, s0)
    o = rmsnorm(o, g_out) * jax.nn.silu(z)
    return o.reshape(b, t, A_WIDTH).astype(hn.dtype) @ w_out, s1, qkv_buf


def conv_ffn(hn, buf, w_up, w_conv, w_down):
    u, buf = causal_dwconv(hn @ w_up, buf, w_conv)
    return (jax.nn.silu(u[..., :D_FF]) * u[..., D_FF:]) @ w_down, buf


def shared_kv(h, pos, g_kv_norm, w_kv, g_k_norm):
    b, t, _ = h.shape
    kv = (rmsnorm(h, g_kv_norm) @ w_kv).reshape(b, t, 2, N_KV_HEADS, HEAD_DIM)
    k = partial_rope(rmsnorm(kv[:, :, 0], g_k_norm), pos)
    return k, kv[:, :, 1]


def dilated_band_prompt(q, k, v, window, dil):
    b, s = q.shape[:2]
    ln = s // dil
    n = window // dil
    nb = -(-ln // n)
    lp = nb * n

    def strided(a):
        a = jnp.moveaxis(a.reshape((b, ln, dil) + a.shape[2:]), 2, 1)
        a = jnp.pad(a, [(0, 0), (0, 0), (0, lp - ln)] + [(0, 0)] * (a.ndim - 3))
        return a.reshape((b, dil, nb, n) + a.shape[3:])

    def with_prev(a):
        prev = jnp.pad(a, [(0, 0), (0, 0), (1, 0)] + [(0, 0)] * (a.ndim - 3))[:, :, :-1]
        return jnp.concatenate([prev, a], axis=3)

    qb = strided(q)
    kw, vw = with_prev(strided(k)), with_prev(strided(v))
    sc = jnp.einsum('brnigec,brnjgc->brngeij', qb, kw, preferred_element_type=F32) * (HEAD_DIM ** -0.5)
    ii = jnp.arange(n)[:, None]
    jj = jnp.arange(2 * n)[None, :]
    dist = n + ii - jj
    band = (dist >= 0) & (dist <= n)
    first = (jnp.arange(nb)[:, None, None] > 0) | (jj >= n)[None]
    mask = band[None] & first
    sc = jnp.where(mask[None, None, :, None, None], sc, -jnp.inf)
    m = jnp.max(sc, axis=-1, keepdims=True)
    pe = jnp.exp(sc - m)
    den = jnp.sum(pe, axis=-1, keepdims=True)
    o = jnp.einsum('brngeij,brnjgc->brnigec', pe, vw)
    o = o / jnp.moveaxis(den[..., 0], -1, 3)[..., None]
    lse = jnp.moveaxis((m + jnp.log(den))[..., 0], -1, 3)

    def unstride(a):
        rest = a.shape[4:]
        a = a.reshape((b, dil, lp) + rest)[:, :, :ln]
        return jnp.moveaxis(a, 1, 2).reshape((b, s) + rest)

    return unstride(o), unstride(lse)


def dilated_gather_sample(q, k, v, cache, window, dil):
    t = q.shape[1]
    wb = cache.shape[1]
    keys = jnp.concatenate([cache[:, :, 0].astype(k.dtype), k], axis=1)
    vals = jnp.concatenate([cache[:, :, 1].astype(v.dtype), v], axis=1)
    n_keys = window // dil + 1
    idx = wb + jnp.arange(t)[:, None] - dil * jnp.arange(n_keys)[None, :]
    valid = idx >= 0
    idx = jnp.maximum(idx, 0)
    kg, vg = keys[:, idx], vals[:, idx]
    sc = jnp.einsum('btgec,btmgc->btgem', q, kg, preferred_element_type=F32) * (HEAD_DIM ** -0.5)
    sc = jnp.where(valid[None, :, None, None, :], sc, -jnp.inf)
    m = jnp.max(sc, axis=-1, keepdims=True)
    pe = jnp.exp(sc - m)
    den = jnp.sum(pe, axis=-1, keepdims=True)
    o = jnp.einsum('btgem,btmgc->btgec', pe, vg) / den
    return o, (m + jnp.log(den))[..., 0]


def dilated_mixer(hn, k_sh, v_sh, pos, w_q, g_q_norm, w_o, caches):
    b, t, _ = hn.shape
    q = (hn @ w_q).reshape(b, t, N_GROUPS, KV_PER_GROUP, Q_REP, HEAD_DIM)
    q = partial_rope(rmsnorm(q, g_q_norm), pos)
    outs, lses = [], []
    for gi, (window, dil) in enumerate(GROUPS):
        sl = slice(gi * KV_PER_GROUP, (gi + 1) * KV_PER_GROUP)
        if caches is None:
            o, lse = dilated_band_prompt(q[:, :, gi], k_sh[:, :, sl], v_sh[:, :, sl], window, dil)
        else:
            o, lse = dilated_gather_sample(q[:, :, gi], k_sh[:, :, sl], v_sh[:, :, sl], caches[gi], window, dil)
        outs.append(o)
        lses.append(lse)
    wts = jax.nn.softmax(jnp.stack(lses, axis=2), axis=2)
    o = jnp.sum(wts[..., None] * jnp.stack(outs, axis=2), axis=2)
    return o.reshape(b, t, Q_PER_GROUP * HEAD_DIM).astype(hn.dtype) @ w_o


def run_trunk(x, p, pos, state, prm):
    is_prompt = state is None
    b, t, _ = x.shape
    dt = x.dtype
    h = x
    new_delta, new_qkv, new_ffn = [], [], []
    k_sh = v_sh = None
    new_kv = None
    for i in range(DEPTH):
        hn = rmsnorm(h, prm['g_mix_norm'][i])
        if i < N_A_LAYERS:
            if is_prompt:
                qkv_buf = jnp.zeros((b, A_CONV - 1, 3 * A_WIDTH), dt)
                s0 = jnp.zeros((b, A_HEADS, A_HEAD_DIM, A_HEAD_DIM), F32)
            else:
                s0, qkv_buf = state[0][i], state[1][i]
            mix, s1, qkv_buf1 = deltanet_mixer(hn, qkv_buf, s0, prm['w_a_in'][i], prm['w_a_conv'][i],
                                               prm['a_log'][i], prm['a_dt_bias'][i], prm['g_a_out_norm'][i],
                                               prm['w_a_out'][i], is_prompt)
            new_delta.append(s1.astype(dt))
            new_qkv.append(qkv_buf1)
        else:
            j = i - N_A_LAYERS
            mix = dilated_mixer(hn, k_sh, v_sh, pos, prm['w_q'][j], prm['g_q_norm'][j], prm['w_o'][j],
                                None if is_prompt else state[3])
        h = h + mix
        ffn_buf = jnp.zeros((b, FFN_CONV - 1, 2 * D_FF), dt) if is_prompt else state[2][i]
        f, ffn_buf1 = conv_ffn(rmsnorm(h, prm['g_ffn_norm'][i]), ffn_buf, prm['w_ffn_up'][i],
                               prm['w_ffn_conv'][i], prm['w_ffn_down'][i])
        h = h + f
        gate = jax.nn.sigmoid(rmsnorm(h, prm['g_ple_norm'][i]) @ prm['w_ple_gate'][i])
        h = h + gate * (p[i] @ prm['w_ple_proj'][i])
        new_ffn.append(ffn_buf1)
        if i == N_A_LAYERS - 1:
            k_sh, v_sh = shared_kv(h, pos, prm['g_kv_norm'], prm['w_kv'], prm['g_k_norm'])
            kv_rows = jnp.stack([k_sh, v_sh], axis=2)
            new_kv = tuple(
                kv_rows[:, t - (min(w, t) if is_prompt else t):, :, gi * KV_PER_GROUP:(gi + 1) * KV_PER_GROUP]
                for gi, (w, _) in enumerate(GROUPS))
    return h, jnp.stack(new_delta), jnp.stack(new_qkv), jnp.stack(new_ffn), new_kv


def setup_inputs(seed: int = 0) -> dict:
    key = jax.random.key(seed)
    ks = iter(jax.random.split(key, 32))

    def nrm(shape, scale):
        return jax.random.normal(next(ks), shape, F32) * scale

    def gain(shape):
        return 1.0 + 0.02 * jax.random.normal(next(ks), shape, F32)

    x_prompt = nrm((BATCH, SEQ, D_MODEL), 1.0)
    x_sample = nrm((DEC_BATCH, DEC_SEQ, D_MODEL), 1.0)
    p_prompt = nrm((DEPTH, BATCH, SEQ, PLE_DIM), 1.0)
    p_sample = nrm((DEPTH, DEC_BATCH, DEC_SEQ, PLE_DIM), 1.0)
    state_delta = nrm((N_A_LAYERS, DEC_BATCH, A_HEADS, A_HEAD_DIM, A_HEAD_DIM), 0.05)
    state_qkv_conv = nrm((N_A_LAYERS, DEC_BATCH, A_CONV - 1, 3 * A_WIDTH), 1.0)
    state_ffn_conv = nrm((DEPTH, DEC_BATCH, FFN_CONV - 1, 2 * D_FF), 1.0)
    cache_kv_w128 = nrm((DEC_BATCH, min(GROUPS[0][0], PAST_LEN), 2, KV_PER_GROUP, HEAD_DIM), 1.0)
    cache_kv_w512 = nrm((DEC_BATCH, min(GROUPS[1][0], PAST_LEN), 2, KV_PER_GROUP, HEAD_DIM), 1.0)
    cache_kv_w2048 = nrm((DEC_BATCH, min(GROUPS[2][0], PAST_LEN), 2, KV_PER_GROUP, HEAD_DIM), 1.0)
    g_mix_norm = gain((DEPTH, D_MODEL))
    g_ffn_norm = gain((DEPTH, D_MODEL))
    w_ffn_up = nrm((DEPTH, D_MODEL, 2 * D_FF), D_MODEL ** -0.5)
    w_ffn_conv = nrm((DEPTH, FFN_CONV, 2 * D_FF), FFN_CONV ** -0.5)
    w_ffn_down = nrm((DEPTH, D_FF, D_MODEL), D_FF ** -0.5)
    g_ple_norm = gain((DEPTH, D_MODEL))
    w_ple_gate = nrm((DEPTH, D_MODEL, D_MODEL), D_MODEL ** -0.5)
    w_ple_proj = nrm((DEPTH, PLE_DIM, D_MODEL), PLE_DIM ** -0.5)
    w_a_in = nrm((N_A_LAYERS, D_MODEL, A_PROJ), D_MODEL ** -0.5)
    w_a_conv = nrm((N_A_LAYERS, A_CONV, 3 * A_WIDTH), A_CONV ** -0.5)
    a_log = jnp.log(jax.random.uniform(next(ks), (N_A_LAYERS, A_HEADS), F32, 1.0, 16.0))
    dt = jnp.exp(jax.random.uniform(next(ks), (N_A_LAYERS, A_HEADS), F32, math.log(1e-3), math.log(1e-1)))
    a_dt_bias = dt + jnp.log(-jnp.expm1(-dt))
    g_a_out_norm = gain((N_A_LAYERS, A_HEAD_DIM))
    w_a_out = nrm((N_A_LAYERS, A_WIDTH, D_MODEL), A_WIDTH ** -0.5)
    g_kv_norm = gain((D_MODEL,))
    w_kv = nrm((D_MODEL, 2 * N_KV_HEADS * HEAD_DIM), D_MODEL ** -0.5)
    g_k_norm = gain((HEAD_DIM,))
    w_q = nrm((N_B_LAYERS, D_MODEL, N_Q_HEADS * HEAD_DIM), D_MODEL ** -0.5)
    g_q_norm = gain((N_B_LAYERS, HEAD_DIM))
    w_o = nrm((N_B_LAYERS, Q_PER_GROUP * HEAD_DIM, D_MODEL), (Q_PER_GROUP * HEAD_DIM) ** -0.5)
    return {'x_prompt': x_prompt, 'x_sample': x_sample, 'p_prompt': p_prompt, 'p_sample': p_sample,
            'state_delta': state_delta, 'state_qkv_conv': state_qkv_conv, 'state_ffn_conv': state_ffn_conv,
            'cache_kv_w128': cache_kv_w128, 'cache_kv_w512': cache_kv_w512, 'cache_kv_w2048': cache_kv_w2048,
            'g_mix_norm': g_mix_norm, 'g_ffn_norm': g_ffn_norm, 'w_ffn_up': w_ffn_up, 'w_ffn_conv': w_ffn_conv,
            'w_ffn_down': w_ffn_down, 'g_ple_norm': g_ple_norm, 'w_ple_gate': w_ple_gate, 'w_ple_proj': w_ple_proj,
            'w_a_in': w_a_in, 'w_a_conv': w_a_conv, 'a_log': a_log, 'a_dt_bias': a_dt_bias,
            'g_a_out_norm': g_a_out_norm, 'w_a_out': w_a_out, 'g_kv_norm': g_kv_norm, 'w_kv': w_kv,
            'g_k_norm': g_k_norm, 'w_q': w_q, 'g_q_norm': g_q_norm, 'w_o': w_o}


def reference(x_prompt, x_sample, p_prompt, p_sample, state_delta, state_qkv_conv, state_ffn_conv,
              cache_kv_w128, cache_kv_w512, cache_kv_w2048, g_mix_norm, g_ffn_norm, w_ffn_up, w_ffn_conv,
              w_ffn_down, g_ple_norm, w_ple_gate, w_ple_proj, w_a_in, w_a_conv, a_log, a_dt_bias,
              g_a_out_norm, w_a_out, g_kv_norm, w_kv, g_k_norm, w_q, g_q_norm, w_o):
    prm = dict(g_mix_norm=g_mix_norm, g_ffn_norm=g_ffn_norm, w_ffn_up=w_ffn_up, w_ffn_conv=w_ffn_conv,
               w_ffn_down=w_ffn_down, g_ple_norm=g_ple_norm, w_ple_gate=w_ple_gate, w_ple_proj=w_ple_proj,
               w_a_in=w_a_in, w_a_conv=w_a_conv, a_log=a_log, a_dt_bias=a_dt_bias,
               g_a_out_norm=g_a_out_norm, w_a_out=w_a_out, g_kv_norm=g_kv_norm, w_kv=w_kv,
               g_k_norm=g_k_norm, w_q=w_q, g_q_norm=g_q_norm, w_o=w_o)
    pos_prompt = jnp.arange(x_prompt.shape[1], dtype=jnp.int32)
    pos_sample = PAST_LEN + jnp.arange(x_sample.shape[1], dtype=jnp.int32)
    y_prompt, sd_p, sq_p, sf_p, kv_p = run_trunk(x_prompt, p_prompt, pos_prompt, None, prm)
    y_sample, sd_s, sq_s, sf_s, kv_s = run_trunk(
        x_sample, p_sample, pos_sample,
        (state_delta, state_qkv_conv, state_ffn_conv, (cache_kv_w128, cache_kv_w512, cache_kv_w2048)), prm)
    kv128_p, kv512_p, kv2048_p = kv_p
    kv128_s, kv512_s, kv2048_s = kv_s
    return (y_prompt, y_sample, sd_p, sq_p, sf_p, kv128_p, kv512_p, kv2048_p,
            sd_s, sq_s, sf_s, kv128_s, kv512_s, kv2048_s)
```

```cpp
#define N_LAUNCH_MODE 0
#include <hip/hip_runtime.h>
#include <hip/hip_cooperative_groups.h>
#include <cstdio>
#include <cstdint>
#include <cmath>
namespace cg = cooperative_groups;

#define LAS __attribute__((address_space(3)))
typedef unsigned short bf16_t;
typedef short bf16x8 __attribute__((ext_vector_type(8)));
typedef short bf16x4 __attribute__((ext_vector_type(4)));
typedef float f32x4 __attribute__((ext_vector_type(4)));
typedef unsigned u32x4 __attribute__((ext_vector_type(4)));
typedef unsigned u32x2 __attribute__((ext_vector_type(2)));

constexpr int T = 16384, SB = 32, MP = 16640, MV = T + SB, D = 1024, DFF = 2816, DFF2 = 5632, PLE = 256;
constexpr float EPS = 1e-6f;
constexpr int NTHREADS = 512;
constexpr int LDS_BYTES = 135168;

constexpr size_t al256(size_t x) { return (x + 255) & ~(size_t)255; }
constexpr size_t WS_WIN = 0;
constexpr size_t WS_WOUT = WS_WIN + (size_t)4096 * 1024 * 2;
constexpr size_t WS_WUP = WS_WOUT + (size_t)1024 * 1024 * 2;
constexpr size_t WS_WDN = WS_WUP + (size_t)2 * 5632 * 1024 * 2;
constexpr size_t WS_WGATE = WS_WDN + (size_t)2 * 1024 * 2816 * 2;
constexpr size_t WS_WPP = WS_WGATE + (size_t)2 * 1024 * 1024 * 2;
constexpr size_t WS_WKVQ = WS_WPP + (size_t)2 * 1024 * 256 * 2;
constexpr size_t WS_WO = WS_WKVQ + (size_t)3072 * 1024 * 2;
constexpr size_t WS_ROPE = WS_WO + (size_t)1024 * 512 * 2;
constexpr size_t WS_AB = al256(WS_ROPE + (size_t)16385 * 16 * 2 * 4);
constexpr size_t WS_SSQA = WS_AB + (size_t)MP * 16 * 4;
constexpr size_t WS_SSQB = WS_SSQA + (size_t)MP * 16 * 4;
constexpr size_t WS_PB = WS_SSQB + (size_t)MP * 16 * 4;
constexpr size_t WS_LSE = WS_PB + (size_t)2 * MP * 256 * 2;
constexpr size_t WS_GEND = WS_LSE + (size_t)3 * MP * 4 * 4;
constexpr size_t WS_HBA = al256(WS_GEND + 2048 * 4);
constexpr size_t WS_HBB = WS_HBA + (size_t)MP * 1024 * 2;
constexpr size_t WS_R2 = WS_HBB + (size_t)MP * 1024 * 2;
constexpr size_t WS_R3 = WS_R2 + (size_t)MP * 4096 * 2;
constexpr size_t WS_QEFF = WS_R3;
constexpr size_t WS_MN = WS_QEFF + (size_t)2048 * 64 * 128 * 2;
constexpr size_t WS_BNT = WS_MN + (size_t)2048 * 128 * 128 * 2;
constexpr size_t WS_R4 = WS_BNT + (size_t)2048 * 128 * 128 * 2;
constexpr size_t WS_END = WS_R4 + (size_t)MP * 1024 * 2;
constexpr size_t WS_U = WS_R2;
constexpr size_t WS_ACT = al256(WS_U + (size_t)MP * 5632 * 2);
static_assert(WS_ACT + (size_t)MP * 2816 * 2 <= WS_R4, "ACT fits");
constexpr size_t WS_KVQ = WS_R2;
constexpr size_t WS_KB = WS_R3;
constexpr size_t WS_QB = WS_KB + (size_t)MP * 768 * 2;
constexpr size_t WS_OG = WS_QB + (size_t)MP * 1536 * 2;
constexpr size_t WS_AM = WS_OG + (size_t)3 * MP * 512 * 2;
static_assert(WS_AM + (size_t)MP * 512 * 2 <= WS_R4, "attention buffers fit");
constexpr size_t WS_OPB = WS_R4, WS_PP = WS_R4;

constexpr size_t O_YP = 0;
constexpr size_t O_YS = O_YP + (size_t)T * D;
constexpr size_t O_SDP = O_YS + (size_t)SB * D;
constexpr size_t O_SQP = O_SDP + 8 * 128 * 128;
constexpr size_t O_SFP = O_SQP + 3 * 3072;
constexpr size_t O_KV128P = O_SFP + 2 * 2 * 5632;
constexpr size_t O_KV512P = O_KV128P + 128 * 512;
constexpr size_t O_KV2048P = O_KV512P + 512 * 512;
constexpr size_t O_SDS = O_KV2048P + 2048 * 512;
constexpr size_t O_SQS = O_SDS + (size_t)SB * 8 * 128 * 128;
constexpr size_t O_SFS = O_SQS + (size_t)SB * 3 * 3072;
constexpr size_t O_KV128S = O_SFS + (size_t)2 * SB * 2 * 5632;
constexpr size_t O_KV512S = O_KV128S + SB * 512;
constexpr size_t O_KV2048S = O_KV512S + SB * 512;
constexpr size_t O_END = O_KV2048S + SB * 512;

struct Params {
    const float* in[30];
    float* out;
    unsigned char* ws;
    double invf[16];
    int ph_lo, ph_hi;
};
enum { I_XP = 0, I_XS, I_PP, I_PS, I_SDELTA, I_SQKV, I_SFFN, I_C128, I_C512, I_C2048, I_GMIX, I_GFFN, I_WUP, I_WFCONV, I_WDN, I_GPLE, I_WGATE, I_WPPROJ,
       I_WAIN, I_WACONV, I_ALOG, I_DTB, I_GAOUT, I_WAOUT, I_GKV, I_WKV, I_GK, I_WQ, I_GQ, I_WO };

__device__ __forceinline__ unsigned f2bf(float f) { unsigned u = __builtin_bit_cast(unsigned, f); return (u + 0x7fffu + ((u >> 16) & 1u)) >> 16; }
__device__ __forceinline__ float bf2f(unsigned h) { return __builtin_bit_cast(float, h << 16); }
__device__ __forceinline__ unsigned pk2(float lo, float hi) { return f2bf(lo) | (f2bf(hi) << 16); }
__device__ __forceinline__ float bflo(unsigned w) { return __builtin_bit_cast(float, w << 16); }
__device__ __forceinline__ float bfhi(unsigned w) { return __builtin_bit_cast(float, w & 0xffff0000u); }
__device__ __forceinline__ float sigmoidf_(float x) { return 1.0f / (1.0f + __expf(-x)); }
__device__ __forceinline__ float siluf_(float x) { return x / (1.0f + __expf(-x)); }
__device__ __forceinline__ float wave_sum(float v) {
#pragma unroll
    for (int o = 32; o >= 1; o >>= 1) v += __shfl_xor(v, o);
    return v;
}
__device__ __forceinline__ float wave_max(float v) {
#pragma unroll
    for (int o = 32; o >= 1; o >>= 1) v = fmaxf(v, __shfl_xor(v, o));
    return v;
}
__device__ __forceinline__ f32x4 mfma16(bf16x8 a, bf16x8 b, f32x4 c) { return __builtin_amdgcn_mfma_f32_16x16x32_bf16(a, b, c, 0, 0, 0); }
__device__ __forceinline__ int opaque_tid() { int t = (int)threadIdx.x; asm volatile("" : "+v"(t)); return t; }
namespace pg8 {
#define PG8_LAS __attribute__((address_space(3)))
typedef unsigned short bf16_t;
typedef short bf16x8 __attribute__((ext_vector_type(8)));
typedef float f32x4 __attribute__((ext_vector_type(4)));
typedef unsigned u32x4 __attribute__((ext_vector_type(4)));
constexpr int BM = 256, BK = 64, HALF = 128, HTB = HALF * BK * 2  , STAGE_BYTES = 8 * HTB, NXCD = 8, WGM = 8;

__host__ __device__ __forceinline__ int lds_byte(int r, int c) { const int st = (r >> 4) * 2 + (c >> 5), rr = r & 15, cc = c & 31, ob = rr * 64 + cc * 2; return st * 1024 + (ob ^ (((ob >> 9) & 1) << 5)); }
__host__ __device__ __forceinline__ void stage_rc(int b, int& R, int& C) { const int st = b / 1024, sb = b % 1024, swz = sb ^ (((sb >> 9) & 1) << 5); R = (st >> 1) * 16 + swz / 64; C = (st & 1) * 32 + (swz % 64) / 2; }
__host__ __device__ __forceinline__ int perm32(int rho) { const int n = rho >> 4, i = rho & 15; return 8 * (i >> 2) + 4 * n + (i & 3); }

struct Unit { int pm, pn; };
struct Gemm { const bf16_t* A; const bf16_t* Bt; int M, N, K; };

struct StaticOrder {
    int nM, nN, nwg, G, c;
    __host__ __device__ void init(int M, int N, int G_, int c_) { nM = M / BM; nN = N / BM; nwg = nM * nN; G = G_; c = c_; }
    __host__ __device__ bool next(int i, Unit& u) const {
        const long L = (long)i * G + c; if (L >= nwg) return false;
        int wgid = (int)L; { const int q = nwg / NXCD, r = nwg % NXCD, xcd = wgid % NXCD, off = wgid / NXCD; wgid = (xcd < r ? xcd * (q + 1) : r * (q + 1) + (xcd - r) * q) + off; }
        const int nig = WGM * nN, gid = wgid / nig, fm = gid * WGM, gsz = (nM - fm) < WGM ? (nM - fm) : WGM;
        u.pm = fm + ((wgid % nig) % gsz); u.pn = (wgid % nig) / gsz; return true;
    }
    __device__ __forceinline__ void a_ready(const Unit&) const {}
    __device__ __forceinline__ void done(const Unit&) const {}
};
__device__ __forceinline__ unsigned cvt_pk_bf16(float lo, float hi) { unsigned r; asm volatile("v_cvt_pk_bf16_f32 %0, %1, %2" : "=v"(r) : "v"(lo), "v"(hi)); return r; }
template <class Epi, class Sched, bool ALIGN_EPI = false, bool SP2 = false>
__device__ __forceinline__ void gemm_phase(PG8_LAS unsigned char* lds, const Gemm g, const Sched& S, const Epi& E) {
    const int tid = opaque_tid(), wid = __builtin_amdgcn_readfirstlane(tid >> 6), lane = tid & 63, wr = wid >> 2, wc = wid & 3, fr = lane & 15, fq = lane >> 4;
    const int K = g.K, nt = K / BK;
    unsigned voffA[2], voffB[2];
#pragma unroll
    for (int i = 0; i < 2; ++i) { int R, C; stage_rc(tid * 16 + i * 8192, R, C); const int Rb = Epi::PERM ? ((R & ~31) + perm32(R & 31)) : R;
        voffA[i] = (unsigned)(R * K + C) * 2u; voffB[i] = (unsigned)(Rb * K + C) * 2u; }
    const size_t kstep = (size_t)(BK * 2);
    const size_t hstep = (size_t)HALF * K * 2;
    const size_t tstep = 2 * hstep;
    const unsigned ldsw = (unsigned)wid * 1024u;
    const int aoff = lds_byte(wr * 64 + fr, fq * 8), boff = lds_byte(wc * 32 + fr, fq * 8);
#define PG8_SA(b, h) (((b) * 2 + (h)) * HTB)
#define PG8_SB(b, h) ((4 + (b) * 2 + (h)) * HTB)
#define PG8_STAGE(bufoff, gbase, voff) do { _Pragma("unroll") for (int _i = 0; _i < 2; ++_i) \
        __builtin_amdgcn_global_load_lds((const unsigned*)((const char*)(gbase) + (voff)[_i]), (PG8_LAS unsigned*)(lds + (bufoff) + ldsw + _i * 8192), 16, 0, 0); } while (0)
#define PG8_LDA(dst, b, h) do { _Pragma("unroll") for (int m = 0; m < 4; ++m) _Pragma("unroll") for (int k = 0; k < 2; ++k) dst[m][k] = *(const PG8_LAS bf16x8*)(lds + PG8_SA(b, h) + aoff + m * 2048 + k * 1024); } while (0)
#define PG8_LDB(dst, b, h) do { _Pragma("unroll") for (int n = 0; n < 2; ++n) _Pragma("unroll") for (int k = 0; k < 2; ++k) dst[n][k] = *(const PG8_LAS bf16x8*)(lds + PG8_SB(b, h) + boff + n * 2048 + k * 1024); } while (0)
#define PG8_MMA(ai, bj, At, Bt) do { __builtin_amdgcn_s_setprio(1); _Pragma("unroll") for (int m = 0; m < 4; ++m) _Pragma("unroll") for (int n = 0; n < 2; ++n) _Pragma("unroll") for (int k = 0; k < 2; ++k) \
        acc[ai][bj][m][n] = __builtin_amdgcn_mfma_f32_16x16x32_bf16(Bt[n][k], At[m][k], acc[ai][bj][m][n], 0, 0, 0); __builtin_amdgcn_s_setprio(0); } while (0)
#define PG8_WAIT_V(n) asm volatile("s_waitcnt vmcnt(" #n ")" ::: "memory")
#define PG8_WAIT_L(n) asm volatile("s_waitcnt lgkmcnt(" #n ")" ::: "memory")
#define PG8_BAR __builtin_amdgcn_s_barrier()
#define PG8_SCHED __builtin_amdgcn_sched_barrier(0)
    Unit cur, nxt; int ui = 0;
    if (!S.next(0, cur)) return;
    f32x4 acc[2][2][4][2];
#pragma unroll
    for (int a = 0; a < 2; ++a)
#pragma unroll
        for (int b = 0; b < 2; ++b)
#pragma unroll
            for (int m = 0; m < 4; ++m)
#pragma unroll
                for (int n = 0; n < 2; ++n) acc[a][b][m][n] = (f32x4){0.f, 0.f, 0.f, 0.f};
    bf16x8 At[4][2], B0[2][2], B1[2][2];
    const char* cA = (const char*)g.A + (size_t)cur.pm * tstep; const char* cB = (const char*)g.Bt + (size_t)cur.pn * tstep;
    S.a_ready(cur);
    if constexpr (SP2) {
        PG8_STAGE(PG8_SB(0, 0), cB, voffB); PG8_STAGE(PG8_SB(0, 1), cB + hstep, voffB); PG8_STAGE(PG8_SA(0, 0), cA, voffA); PG8_STAGE(PG8_SA(0, 1), cA + hstep, voffA);
        if (wr == 1) PG8_BAR;
        PG8_WAIT_V(2); PG8_BAR;
        PG8_STAGE(PG8_SB(1, 0), cB + kstep, voffB); PG8_STAGE(PG8_SA(1, 0), cA + kstep, voffA); PG8_STAGE(PG8_SB(1, 1), cB + hstep + kstep, voffB);
        PG8_WAIT_V(6); PG8_BAR;
    } else {
        PG8_STAGE(PG8_SB(0, 0), cB, voffB); PG8_STAGE(PG8_SA(0, 0), cA, voffA); PG8_STAGE(PG8_SB(0, 1), cB + hstep, voffB); PG8_STAGE(PG8_SA(0, 1), cA + hstep, voffA);
        if (wr == 1) PG8_BAR;
        PG8_WAIT_V(4); PG8_BAR;
        PG8_STAGE(PG8_SB(1, 0), cB + kstep, voffB); PG8_STAGE(PG8_SA(1, 0), cA + kstep, voffA); PG8_STAGE(PG8_SB(1, 1), cB + hstep + kstep, voffB);
        PG8_WAIT_V(6); PG8_BAR;
    }
    for (;;) {
        const bool has_next = S.next(ui + 1, nxt);
        const char* nA = has_next ? (const char*)g.A + (size_t)nxt.pm * tstep : cA; const char* nB = has_next ? (const char*)g.Bt + (size_t)nxt.pn * tstep : cB;
        for (int t = 0; t < nt; t += 2) {
            const bool last = (t == nt - 2);
            const char* a1 = cA + (size_t)(t + 1) * kstep;
            const char* a2 = last ? nA : cA + (size_t)(t + 2) * kstep; const char* b2 = last ? nB : cB + (size_t)(t + 2) * kstep;
            const char* a3 = a2 + kstep; const char* b3 = b2 + kstep;
            if (last && has_next) S.a_ready(nxt);
            if constexpr (SP2) {
            PG8_LDB(B0, 0, 0); PG8_LDB(B1, 0, 1); PG8_SCHED; PG8_LDA(At, 0, 0); PG8_STAGE(PG8_SA(1, 1), a1 + hstep, voffA);
            PG8_WAIT_V(8); PG8_WAIT_L(0); PG8_BAR; PG8_MMA(0, 0, At, B0); PG8_MMA(0, 1, At, B1); PG8_BAR; PG8_SCHED;
            PG8_LDA(At, 0, 1); PG8_STAGE(PG8_SB(0, 0), b2, voffB); PG8_STAGE(PG8_SB(0, 1), b2 + hstep, voffB); PG8_STAGE(PG8_SA(0, 0), a2, voffA);
            PG8_WAIT_V(8); PG8_WAIT_L(0); PG8_BAR; PG8_MMA(1, 0, At, B0); PG8_MMA(1, 1, At, B1); PG8_BAR; PG8_SCHED;
            PG8_LDB(B0, 1, 0); PG8_LDB(B1, 1, 1); PG8_SCHED; PG8_LDA(At, 1, 0); PG8_STAGE(PG8_SA(0, 1), a2 + hstep, voffA);
            PG8_WAIT_V(8); PG8_WAIT_L(0); PG8_BAR; PG8_MMA(0, 0, At, B0); PG8_MMA(0, 1, At, B1); PG8_BAR; PG8_SCHED;
            PG8_LDA(At, 1, 1); PG8_STAGE(PG8_SB(1, 0), b3, voffB); PG8_STAGE(PG8_SB(1, 1), b3 + hstep, voffB); PG8_STAGE(PG8_SA(1, 0), a3, voffA);
            PG8_WAIT_V(8); PG8_WAIT_L(0); PG8_BAR; PG8_MMA(1, 0, At, B0); PG8_MMA(1, 1, At, B1); PG8_BAR; PG8_SCHED;
            } else {
            PG8_LDB(B0, 0, 0); PG8_SCHED; PG8_LDA(At, 0, 0); PG8_STAGE(PG8_SA(1, 1), a1 + hstep, voffA);
            PG8_WAIT_L(8); PG8_BAR; PG8_WAIT_L(0); PG8_MMA(0, 0, At, B0); PG8_BAR; PG8_SCHED;
            PG8_LDB(B1, 0, 1); PG8_STAGE(PG8_SB(0, 0), b2, voffB);
            PG8_BAR; PG8_WAIT_L(0); PG8_MMA(0, 1, At, B1); PG8_BAR;
            PG8_LDA(At, 0, 1); PG8_STAGE(PG8_SA(0, 0), a2, voffA);
            PG8_BAR; PG8_WAIT_L(0); PG8_MMA(1, 0, At, B0); PG8_BAR; PG8_SCHED;
            PG8_STAGE(PG8_SB(0, 1), b2 + hstep, voffB);
            PG8_WAIT_V(6); PG8_BAR; PG8_MMA(1, 1, At, B1); PG8_BAR;
            PG8_LDB(B0, 1, 0); PG8_SCHED; PG8_LDA(At, 1, 0); PG8_STAGE(PG8_SA(0, 1), a2 + hstep, voffA);
            PG8_WAIT_L(8); PG8_BAR; PG8_WAIT_L(0); PG8_MMA(0, 0, At, B0); PG8_BAR; PG8_SCHED;
            PG8_LDB(B1, 1, 1); PG8_STAGE(PG8_SB(1, 0), b3, voffB);
            PG8_BAR; PG8_WAIT_L(0); PG8_MMA(0, 1, At, B1); PG8_BAR;
            PG8_LDA(At, 1, 1); PG8_STAGE(PG8_SA(1, 0), a3, voffA);
            PG8_BAR; PG8_WAIT_L(0); PG8_MMA(1, 0, At, B0); PG8_BAR; PG8_SCHED;
            PG8_STAGE(PG8_SB(1, 1), b3 + hstep, voffB);
            PG8_WAIT_V(6); PG8_BAR; PG8_MMA(1, 1, At, B1); PG8_BAR;
            }
        }
        if constexpr (ALIGN_EPI) { if (wr == 0) PG8_BAR; }
        if constexpr (!Epi::AFTER_DRAIN) { E(acc, cur, wr, wc, fr, fq); S.done(cur); }
        if (!has_next) break;
#pragma unroll
        for (int a = 0; a < 2; ++a)
#pragma unroll
            for (int b = 0; b < 2; ++b)
#pragma unroll
                for (int m = 0; m < 4; ++m)
#pragma unroll
                    for (int n = 0; n < 2; ++n) acc[a][b][m][n] = (f32x4){0.f, 0.f, 0.f, 0.f};
        cur = nxt; cA = nA; cB = nB; ++ui;
        if constexpr (ALIGN_EPI) { if (wr == 1) PG8_BAR; }
    }
    PG8_WAIT_V(0);
    if constexpr (!ALIGN_EPI) { if (wr == 0) PG8_BAR; }
    PG8_BAR;
    if constexpr (Epi::AFTER_DRAIN) { E.fused(acc, cur, wr, wc, fr, fq, lds, wid, lane); S.done(cur); }
#undef PG8_SA
#undef PG8_SB
#undef PG8_STAGE
#undef PG8_LDA
#undef PG8_LDB
#undef PG8_MMA
#undef PG8_WAIT_V
#undef PG8_WAIT_L
#undef PG8_BAR
#undef PG8_SCHED
}
}

extern __shared__ __attribute__((aligned(16))) unsigned char smem[];

struct TJob { const float* src; int lds; int col0; int ncols; int K; const float* gain; bf16_t* dst; };
constexpr int NJOBS = 14;
__device__ __forceinline__ void get_job(const Params& p, int j, TJob& J) {
    bf16_t* ws = (bf16_t*)p.ws;
    switch (j) {
    case 0: J = {p.in[I_WAIN], 4112, 0, 3072, 1024, p.in[I_GMIX], (bf16_t*)(p.ws + WS_WIN)}; break;
    case 1: J = {p.in[I_WAIN], 4112, 3088, 1024, 1024, p.in[I_GMIX], (bf16_t*)(p.ws + WS_WIN) + (size_t)3072 * 1024}; break;
    case 2: J = {p.in[I_WAOUT], 1024, 0, 1024, 1024, nullptr, (bf16_t*)(p.ws + WS_WOUT)}; break;
    case 3: J = {p.in[I_WUP], 5632, 0, 5632, 1024, p.in[I_GFFN], (bf16_t*)(p.ws + WS_WUP)}; break;
    case 4: J = {p.in[I_WUP] + (size_t)1024 * 5632, 5632, 0, 5632, 1024, p.in[I_GFFN] + 1024, (bf16_t*)(p.ws + WS_WUP) + (size_t)5632 * 1024}; break;
    case 5: J = {p.in[I_WDN], 1024, 0, 1024, 2816, nullptr, (bf16_t*)(p.ws + WS_WDN)}; break;
    case 6: J = {p.in[I_WDN] + (size_t)2816 * 1024, 1024, 0, 1024, 2816, nullptr, (bf16_t*)(p.ws + WS_WDN) + (size_t)1024 * 2816}; break;
    case 7: J = {p.in[I_WGATE], 1024, 0, 1024, 1024, p.in[I_GPLE], (bf16_t*)(p.ws + WS_WGATE)}; break;
    case 8: J = {p.in[I_WGATE] + (size_t)1024 * 1024, 1024, 0, 1024, 1024, p.in[I_GPLE] + 1024, (bf16_t*)(p.ws + WS_WGATE) + (size_t)1024 * 1024}; break;
    case 9: J = {p.in[I_WPPROJ], 1024, 0, 1024, 256, nullptr, (bf16_t*)(p.ws + WS_WPP)}; break;
    case 10: J = {p.in[I_WPPROJ] + (size_t)256 * 1024, 1024, 0, 1024, 256, nullptr, (bf16_t*)(p.ws + WS_WPP) + (size_t)1024 * 256}; break;
    case 11: J = {p.in[I_WKV], 1536, 0, 1536, 1024, p.in[I_GKV], (bf16_t*)(p.ws + WS_WKVQ)}; break;
    case 12: J = {p.in[I_WQ], 1536, 0, 1536, 1024, p.in[I_GMIX] + 1024, (bf16_t*)(p.ws + WS_WKVQ) + (size_t)1536 * 1024}; break;
    default: J = {p.in[I_WO], 1024, 0, 1024, 512, nullptr, (bf16_t*)(p.ws + WS_WO)}; break;
    }
    (void)ws;
}
__device__ __forceinline__ int job_tiles(int j) {
    switch (j) { case 0: return 768; case 1: return 256; case 2: return 256; case 3: case 4: return 1408; case 5: case 6: return 704; case 7: case 8: return 256;
                 case 9: case 10: return 64; case 11: case 12: return 384; default: return 128; }
}
constexpr int TOTAL_TTILES = 768 + 256 + 256 + 2 * 1408 + 2 * 704 + 2 * 256 + 2 * 64 + 2 * 384 + 128;

__device__ __forceinline__ void p0_prologue(const Params& p) {
    const int tid = opaque_tid(), lane = tid & 63, wid = tid >> 6;
    float* tile = (float*)smem;
    for (int it = blockIdx.x; it < TOTAL_TTILES; it += gridDim.x) {
        int j = 0, rem = it;
        while (rem >= job_tiles(j)) { rem -= job_tiles(j); ++j; }
        TJob J; get_job(p, j, J);
        const int nkt = J.K / 64; const int ntile = rem / nkt, ktile = rem % nkt; const int n0 = ntile * 64, k0 = ktile * 64;
        {
            const int kk = tid >> 4, n4 = (tid & 15) * 4;
#pragma unroll
            for (int h = 0; h < 2; ++h) {
                const int k = kk + h * 32;
                f32x4 v = *(const f32x4*)(J.src + (size_t)(k0 + k) * J.lds + J.col0 + n0 + n4);
                const float g = J.gain ? J.gain[k0 + k] : 1.0f;
                tile[k * 65 + n4 + 0] = v[0] * g; tile[k * 65 + n4 + 1] = v[1] * g; tile[k * 65 + n4 + 2] = v[2] * g; tile[k * 65 + n4 + 3] = v[3] * g;
            }
        }
        __syncthreads();
        {
            const int n = tid >> 3, k8 = (tid & 7) * 8;
            u32x4 w;
            w[0] = pk2(tile[(k8 + 0) * 65 + n], tile[(k8 + 1) * 65 + n]); w[1] = pk2(tile[(k8 + 2) * 65 + n], tile[(k8 + 3) * 65 + n]);
            w[2] = pk2(tile[(k8 + 4) * 65 + n], tile[(k8 + 5) * 65 + n]); w[3] = pk2(tile[(k8 + 6) * 65 + n], tile[(k8 + 7) * 65 + n]);
            *(u32x4*)(J.dst + (size_t)(n0 + n) * J.K + k0 + k8) = w;
        }
        __syncthreads();
    }
    bf16_t* HBA = (bf16_t*)(p.ws + WS_HBA); bf16_t* HBB = (bf16_t*)(p.ws + WS_HBB);
    float* SSQA = (float*)(p.ws + WS_SSQA); float* SSQB = (float*)(p.ws + WS_SSQB); float* AB = (float*)(p.ws + WS_AB);
    const float* gmix = p.in[I_GMIX]; const float* wain = p.in[I_WAIN];
    for (int r = blockIdx.x * 8 + wid; r < MP; r += gridDim.x * 8) {
        if (r < MV) {
            const float* src = r < T ? p.in[I_XP] + (size_t)r * D : p.in[I_XS] + (size_t)(r - T) * D;
            f32x4 xv[4]; float ssq = 0.f;
#pragma unroll
            for (int i = 0; i < 4; ++i) { xv[i] = *(const f32x4*)(src + i * 256 + lane * 4); ssq += xv[i][0] * xv[i][0] + xv[i][1] * xv[i][1] + xv[i][2] * xv[i][2] + xv[i][3] * xv[i][3]; }
            ssq = wave_sum(ssq);
#pragma unroll
            for (int i = 0; i < 4; ++i) { u32x2 w; w[0] = pk2(xv[i][0], xv[i][1]); w[1] = pk2(xv[i][2], xv[i][3]); *(u32x2*)(HBA + (size_t)r * D + i * 256 + lane * 4) = w; }
            float dots[16];
#pragma unroll
            for (int j = 0; j < 16; ++j) dots[j] = 0.f;
#pragma unroll
            for (int i = 0; i < 4; ++i)
#pragma unroll
                for (int e = 0; e < 4; ++e) {
                    const int k = i * 256 + lane * 4 + e; const float xg = xv[i][e] * gmix[k];
                    const f32x4* wp = (const f32x4*)(wain + (size_t)k * 4112 + 3072);
#pragma unroll
                    for (int q = 0; q < 4; ++q) { f32x4 w = wp[q]; dots[q * 4 + 0] += xg * w[0]; dots[q * 4 + 1] += xg * w[1]; dots[q * 4 + 2] += xg * w[2]; dots[q * 4 + 3] += xg * w[3]; }
                }
            const float rstd = rsqrtf(ssq * (1.0f / 1024.0f) + EPS);
            float mine = 0.f;
#pragma unroll
            for (int j = 0; j < 16; ++j) { const float s = wave_sum(dots[j]); if (lane == j) mine = s * rstd; }
            if (lane < 16) { AB[(size_t)r * 16 + lane] = mine; SSQA[(size_t)r * 16 + lane] = (lane == 0) ? ssq : 0.f; }
        } else {
            u32x2 z; z[0] = 0u; z[1] = 0u;
#pragma unroll
            for (int i = 0; i < 4; ++i) { *(u32x2*)(HBA + (size_t)r * D + i * 256 + lane * 4) = z; *(u32x2*)(HBB + (size_t)r * D + i * 256 + lane * 4) = z; }
            if (lane < 16) { AB[(size_t)r * 16 + lane] = 0.f; SSQA[(size_t)r * 16 + lane] = (lane == 0) ? 1024.f : 0.f; SSQB[(size_t)r * 16 + lane] = (lane == 0) ? 1024.f : 0.f; }
        }
    }
    bf16_t* PB = (bf16_t*)(p.ws + WS_PB);
    for (int i = blockIdx.x * NTHREADS + tid; i < 2 * MV * 32; i += gridDim.x * NTHREADS) {
        const int l = i / (MV * 32), rem = i % (MV * 32), r = rem >> 5, c8 = (rem & 31) * 8;
        const float* src = r < T ? p.in[I_PP] + ((size_t)l * T + r) * PLE + c8 : p.in[I_PS] + ((size_t)l * SB + (r - T)) * PLE + c8;
        f32x4 a = *(const f32x4*)src, b = *(const f32x4*)(src + 4);
        u32x4 w; w[0] = pk2(a[0], a[1]); w[1] = pk2(a[2], a[3]); w[2] = pk2(b[0], b[1]); w[3] = pk2(b[2], b[3]);
        *(u32x4*)(PB + ((size_t)l * MP + r) * PLE + c8) = w;
    }
    float* ROPE = (float*)(p.ws + WS_ROPE);
    for (int i = blockIdx.x * NTHREADS + tid; i < 16385 * 16; i += gridDim.x * NTHREADS) {
        const int t = i >> 4, f = i & 15;
        const double rev = (double)t * p.invf[f] * 0.15915494309189533577;
        const float fr = (float)(rev - rint(rev));
        ROPE[(size_t)i * 2 + 0] = __builtin_amdgcn_cosf(fr);
        ROPE[(size_t)i * 2 + 1] = __builtin_amdgcn_sinf(fr);
    }
}

__device__ __forceinline__ float rstd_from(const float* ssq, int row) {
    const f32x4* s = (const f32x4*)(ssq + (size_t)row * 16);
    const f32x4 a = s[0], b = s[1], c = s[2], d = s[3];
    const float tot = ((a[0] + a[1]) + (a[2] + a[3])) + ((b[0] + b[1]) + (b[2] + b[3])) + ((c[0] + c[1]) + (c[2] + c[3])) + ((d[0] + d[1]) + (d[2] + d[3]));
    return rsqrtf(tot * (1.0f / 1024.0f) + EPS);
}
struct EpiScale {
    static constexpr bool PERM = false, AFTER_DRAIN = false;
    bf16_t* O; int ldc; const float* ssq;
    __device__ __forceinline__ void operator()(const pg8::f32x4 (&acc)[2][2][4][2], const pg8::Unit& u, int wr, int wc, int fr, int fq) const {
#pragma unroll
        for (int ai = 0; ai < 2; ++ai)
#pragma unroll
            for (int m = 0; m < 4; ++m) {
                const int row = u.pm * 256 + ai * 128 + wr * 64 + m * 16 + fr;
                const float sc = ssq ? rstd_from(ssq, row) : 1.0f;
                bf16_t* rowp = O + (size_t)row * ldc + u.pn * 256 + wc * 32 + 4 * fq;
#pragma unroll
                for (int bj = 0; bj < 2; ++bj)
#pragma unroll
                    for (int n = 0; n < 2; ++n) {
                        const pg8::f32x4 v = acc[ai][bj][m][n] * sc;
                        u32x2 w; w[0] = pg8::cvt_pk_bf16(v[0], v[1]); w[1] = pg8::cvt_pk_bf16(v[2], v[3]);
                        *(u32x2*)(rowp + bj * 128 + n * 16) = w;
                    }
            }
    }
};
struct EpiResid {
    static constexpr bool PERM = false, AFTER_DRAIN = false;
    const float* hin_p; const float* hin_s; float* yp; float* ys; bf16_t* HB; float* ssq_out; const float* ssq_in; const bf16_t* PPb; int gate;
    __device__ __forceinline__ void operator()(const pg8::f32x4 (&acc)[2][2][4][2], const pg8::Unit& u, int wr, int wc, int fr, int fq) const {
#pragma unroll
        for (int ai = 0; ai < 2; ++ai)
#pragma unroll
            for (int m = 0; m < 4; ++m) {
                const int row = u.pm * 256 + ai * 128 + wr * 64 + m * 16 + fr;
                if (row < MV) {
                    const float* hi = row < T ? hin_p + (size_t)row * D : hin_s + (size_t)(row - T) * D;
                    float* ho = row < T ? yp + (size_t)row * D : ys + (size_t)(row - T) * D;
                    const float sc = gate ? rstd_from(ssq_in, row) : 1.0f;
                    const int col0 = u.pn * 256 + wc * 32 + 4 * fq;
                    float part = 0.f;
#pragma unroll
                    for (int bj = 0; bj < 2; ++bj)
#pragma unroll
                        for (int n = 0; n < 2; ++n) {
                            const int col = col0 + bj * 128 + n * 16;
                            const pg8::f32x4 h = *(const pg8::f32x4*)(hi + col);
                            pg8::f32x4 a = acc[ai][bj][m][n], v;
                            if (gate) {
                                const u32x2 pw = *(const u32x2*)(PPb + (size_t)row * D + col);
                                v[0] = h[0] + sigmoidf_(a[0] * sc) * bflo(pw[0]); v[1] = h[1] + sigmoidf_(a[1] * sc) * bfhi(pw[0]);
                                v[2] = h[2] + sigmoidf_(a[2] * sc) * bflo(pw[1]); v[3] = h[3] + sigmoidf_(a[3] * sc) * bfhi(pw[1]);
                            } else v = h + a;
                            *(pg8::f32x4*)(ho + col) = v;
                            u32x2 w; w[0] = pg8::cvt_pk_bf16(v[0], v[1]); w[1] = pg8::cvt_pk_bf16(v[2], v[3]);
                            *(u32x2*)(HB + (size_t)row * D + col) = w;
                            part += (v[0] * v[0] + v[1] * v[1]) + (v[2] * v[2] + v[3] * v[3]);
                        }
                    part += __shfl_xor(part, 16); part += __shfl_xor(part, 32);
                    if (fq == 0) ssq_out[(size_t)row * 16 + u.pn * 4 + wc] = part;
                }
            }
    }
};
template <class Epi>
__device__ __forceinline__ void run_gemm(const bf16_t* A, const bf16_t* Bt, int N, int K, const Epi& E) {
    pg8::Gemm g{A, Bt, MP, N, K};
    pg8::StaticOrder S; S.init(MP, N, (int)gridDim.x, (int)blockIdx.x);
    pg8::gemm_phase<Epi, pg8::StaticOrder, false, true>((PG8_LAS unsigned char*)smem, g, S, E);
    __syncthreads();
}

constexpr int LK = 136, LT = 72;
constexpr int D1_SK = 0;
constexpr int D1_SQ = D1_SK + 64 * LK * 2;
constexpr int D1_SKT = D1_SQ + 64 * LK * 2;
constexpr int D1_SWT = D1_SKT + 128 * LT * 2;
constexpr int D1_SVT = D1_SWT + 128 * LT * 2;
constexpr int D1_SQK = D1_SVT + 128 * LT * 2;
constexpr int D1_SL = D1_SQK + 64 * LT * 2;
constexpr int D1_VEC = D1_SL + 64 * 64 * 4;
static_assert(D1_VEC + 4 * 64 * 4 <= LDS_BYTES, "D1 LDS");

__device__ __forceinline__ float softplusf_(float x) { return x > 20.f ? x : log1pf(__expf(x)); }

__device__ __forceinline__ void d1_unit(const Params& p, int n, int h) {
    const int tid = opaque_tid(), lane = tid & 63, wid = tid >> 6, r16 = lane & 15, q4 = lane >> 4;
    bf16_t* sK = (bf16_t*)(smem + D1_SK); bf16_t* sQ = (bf16_t*)(smem + D1_SQ); bf16_t* sKT = (bf16_t*)(smem + D1_SKT);
    bf16_t* sWT = (bf16_t*)(smem + D1_SWT); bf16_t* sVT = (bf16_t*)(smem + D1_SVT); bf16_t* sQK = (bf16_t*)(smem + D1_SQK);
    float* sL = (float*)(smem + D1_SL); float* sBeta = (float*)(smem + D1_VEC); float* sGc = sBeta + 64; float* sGam = sBeta + 128; float* sEgl = sBeta + 192;
    const bf16_t* PROJ = (const bf16_t*)(p.ws + WS_R2);
    const float* AB = (const float*)(p.ws + WS_AB);
    const float* wconv = p.in[I_WACONV];
    {
        const int i = tid >> 3, s = tid & 7, t = n * 64 + i, f0 = s * 16;
#pragma unroll 1
        for (int part = 0; part < 3; ++part) {
            const int col = part * 1024 + h * 128 + f0;
            float a[16];
#pragma unroll
            for (int e = 0; e < 16; ++e) a[e] = 0.f;
#pragma unroll
            for (int j = 0; j < 4; ++j) {
                const int row = t - 3 + j;
                if (row >= 0) {
                    const u32x4 x0 = *(const u32x4*)(PROJ + (size_t)row * 4096 + col), x1 = *(const u32x4*)(PROJ + (size_t)row * 4096 + col + 8);
                    const f32x4* wp = (const f32x4*)(wconv + (size_t)j * 3072 + col);
                    const f32x4 w0 = wp[0], w1 = wp[1], w2 = wp[2], w3 = wp[3];
                    a[0] += bflo(x0[0]) * w0[0]; a[1] += bfhi(x0[0]) * w0[1]; a[2] += bflo(x0[1]) * w0[2]; a[3] += bfhi(x0[1]) * w0[3];
                    a[4] += bflo(x0[2]) * w1[0]; a[5] += bfhi(x0[2]) * w1[1]; a[6] += bflo(x0[3]) * w1[2]; a[7] += bfhi(x0[3]) * w1[3];
                    a[8] += bflo(x1[0]) * w2[0]; a[9] += bfhi(x1[0]) * w2[1]; a[10] += bflo(x1[1]) * w2[2]; a[11] += bfhi(x1[1]) * w2[3];
                    a[12] += bflo(x1[2]) * w3[0]; a[13] += bfhi(x1[2]) * w3[1]; a[14] += bflo(x1[3]) * w3[2]; a[15] += bfhi(x1[3]) * w3[3];
                }
            }
            float ss = 0.f;
#pragma unroll
            for (int e = 0; e < 16; ++e) { a[e] = siluf_(a[e]); ss += a[e] * a[e]; }
            if (part < 2) {
                ss += __shfl_xor(ss, 1); ss += __shfl_xor(ss, 2); ss += __shfl_xor(ss, 4);
                float rs = rsqrtf(ss + EPS); if (part == 0) rs *= 0.08838834764831845f;
#pragma unroll
                for (int e = 0; e < 16; ++e) a[e] *= rs;
            }
            if (part == 0) {
                u32x4 w0, w1;
                w0[0] = pk2(a[0], a[1]); w0[1] = pk2(a[2], a[3]); w0[2] = pk2(a[4], a[5]); w0[3] = pk2(a[6], a[7]);
                w1[0] = pk2(a[8], a[9]); w1[1] = pk2(a[10], a[11]); w1[2] = pk2(a[12], a[13]); w1[3] = pk2(a[14], a[15]);
                *(u32x4*)(sQ + i * LK + f0) = w0; *(u32x4*)(sQ + i * LK + f0 + 8) = w1;
            } else if (part == 1) {
                u32x4 w0, w1;
                w0[0] = pk2(a[0], a[1]); w0[1] = pk2(a[2], a[3]); w0[2] = pk2(a[4], a[5]); w0[3] = pk2(a[6], a[7]);
                w1[0] = pk2(a[8], a[9]); w1[1] = pk2(a[10], a[11]); w1[2] = pk2(a[12], a[13]); w1[3] = pk2(a[14], a[15]);
                *(u32x4*)(sK + i * LK + f0) = w0; *(u32x4*)(sK + i * LK + f0 + 8) = w1;
#pragma unroll
                for (int e = 0; e < 16; ++e) sKT[(f0 + e) * LT + i] = (bf16_t)f2bf(a[e]);
            } else {
#pragma unroll
                for (int e = 0; e < 16; ++e) sVT[(f0 + e) * LT + i] = (bf16_t)f2bf(a[e]);
            }
        }
        if (s == 0) {
            const float av = AB[(size_t)t * 16 + h], bv = AB[(size_t)t * 16 + 8 + h];
            const float g = -__expf(p.in[I_ALOG][h]) * softplusf_(av + p.in[I_DTB][h]);
            sGc[i] = g; sBeta[i] = sigmoidf_(bv);
        }
    }
    __syncthreads();
    if (wid == 0) {
        float g = sGc[lane];
#pragma unroll
        for (int o = 1; o < 64; o <<= 1) { const float t2 = __shfl_up(g, o); if (lane >= o) g += t2; }
        const float gl = __shfl(g, 63);
        sGc[lane] = g; sGam[lane] = __expf(g); sEgl[lane] = __expf(gl - g);
        if (lane == 63) ((float*)(p.ws + WS_GEND))[n * 8 + h] = __expf(gl);
    }
    __syncthreads();
#pragma unroll 1
    for (int tt = wid; tt < 16; tt += 8) {
        const int mt = tt >> 2, nt = tt & 3;
        f32x4 akk = {0.f, 0.f, 0.f, 0.f}, aqk = {0.f, 0.f, 0.f, 0.f};
        if (mt >= nt) {
#pragma unroll
            for (int ks = 0; ks < 4; ++ks) {
                const bf16x8 bk = *(const bf16x8*)(sK + (16 * nt + r16) * LK + ks * 32 + q4 * 8);
                const bf16x8 ak = *(const bf16x8*)(sK + (16 * mt + r16) * LK + ks * 32 + q4 * 8);
                const bf16x8 aq = *(const bf16x8*)(sQ + (16 * mt + r16) * LK + ks * 32 + q4 * 8);
                akk = mfma16(ak, bk, akk); aqk = mfma16(aq, bk, aqk);
            }
        }
        const int jj = 16 * nt + r16; const float gj = sGc[jj];
#pragma unroll
        for (int e = 0; e < 4; ++e) {
            const int i = 16 * mt + q4 * 4 + e;
            const float dec = (i >= jj) ? __expf(sGc[i] - gj) : 0.f;
            sL[i * 64 + jj] = (i > jj) ? sBeta[i] * akk[e] * dec : 0.f;
            sQK[i * LT + jj] = (bf16_t)f2bf(aqk[e] * dec);
        }
    }
    __syncthreads();
    if (tid < 256) {
        const int c = tid & 127; const bool isw = tid >= 128;
        const bf16_t* src = (isw ? sKT : sVT) + c * LT;
        bf16_t* dst = (isw ? sWT : sVT) + c * LT;
#pragma unroll 1
        for (int b = 0; b < 4; ++b) {
            float r[16];
            {
                const u32x4 r0 = *(const u32x4*)(src + b * 16), r1 = *(const u32x4*)(src + b * 16 + 8);
#pragma unroll
                for (int e = 0; e < 4; ++e) { r[2 * e] = bflo(r0[e]); r[2 * e + 1] = bfhi(r0[e]); r[8 + 2 * e] = bflo(r1[e]); r[8 + 2 * e + 1] = bfhi(r1[e]); }
#pragma unroll
                for (int i = 0; i < 16; ++i) { float sc = sBeta[b * 16 + i]; if (isw) sc *= sGam[b * 16 + i]; r[i] *= sc; }
            }
#pragma unroll 1
            for (int j8 = 0; j8 < 2 * b; ++j8) {
                const u32x4 xr = *(const u32x4*)(dst + j8 * 8);
                float xp[8];
#pragma unroll
                for (int e = 0; e < 4; ++e) { xp[2 * e] = bflo(xr[e]); xp[2 * e + 1] = bfhi(xr[e]); }
#pragma unroll
                for (int i = 0; i < 16; ++i) {
                    const f32x4 l0 = *(const f32x4*)(sL + (b * 16 + i) * 64 + j8 * 8), l1 = *(const f32x4*)(sL + (b * 16 + i) * 64 + j8 * 8 + 4);
                    r[i] -= (l0[0] * xp[0] + l0[1] * xp[1]) + (l0[2] * xp[2] + l0[3] * xp[3]) + (l1[0] * xp[4] + l1[1] * xp[5]) + (l1[2] * xp[6] + l1[3] * xp[7]);
                }
            }
#pragma unroll
            for (int i = 1; i < 16; ++i) {
                float s0 = 0.f;
#pragma unroll
                for (int j4 = 0; j4 < (i + 3) / 4; ++j4) {
                    const f32x4 l = *(const f32x4*)(sL + (b * 16 + i) * 64 + b * 16 + j4 * 4);
                    s0 += l[0] * r[j4 * 4 + 0];
                    if (j4 * 4 + 1 < i) s0 += l[1] * r[j4 * 4 + 1];
                    if (j4 * 4 + 2 < i) s0 += l[2] * r[j4 * 4 + 2];
                    if (j4 * 4 + 3 < i) s0 += l[3] * r[j4 * 4 + 3];
                }
                r[i] -= s0;
            }
            u32x4 w0, w1;
            w0[0] = pk2(r[0], r[1]); w0[1] = pk2(r[2], r[3]); w0[2] = pk2(r[4], r[5]); w0[3] = pk2(r[6], r[7]);
            w1[0] = pk2(r[8], r[9]); w1[1] = pk2(r[10], r[11]); w1[2] = pk2(r[12], r[13]); w1[3] = pk2(r[14], r[15]);
            *(u32x4*)(dst + b * 16) = w0; *(u32x4*)(dst + b * 16 + 8) = w1;
        }
        if (isw) {
#pragma unroll
            for (int v = 0; v < 8; ++v) {
                const u32x4 raw = *(const u32x4*)(sKT + c * LT + v * 8);
                u32x4 w;
#pragma unroll
                for (int e = 0; e < 4; ++e) w[e] = pk2(bflo(raw[e]) * sEgl[v * 8 + 2 * e], bfhi(raw[e]) * sEgl[v * 8 + 2 * e + 1]);
                *(u32x4*)(sKT + c * LT + v * 8) = w;
            }
        }
    }
    __syncthreads();
    const int ch = n * 8 + h;
    bf16_t* QEFF = (bf16_t*)(p.ws + WS_QEFF) + (size_t)ch * 64 * 128;
    bf16_t* MN = (bf16_t*)(p.ws + WS_MN) + (size_t)ch * 128 * 128;
    bf16_t* BNT = (bf16_t*)(p.ws + WS_BNT) + (size_t)ch * 128 * 128;
    bf16_t* OPB = (bf16_t*)(p.ws + WS_OPB);
    {
        const int nt = wid;
        bf16x8 bw[2], bu[2];
#pragma unroll
        for (int ks = 0; ks < 2; ++ks) { bw[ks] = *(const bf16x8*)(sWT + (16 * nt + r16) * LT + ks * 32 + q4 * 8); bu[ks] = *(const bf16x8*)(sVT + (16 * nt + r16) * LT + ks * 32 + q4 * 8); }
#pragma unroll
        for (int mt = 0; mt < 4; ++mt) {
            f32x4 a1 = {0.f, 0.f, 0.f, 0.f}, a2 = {0.f, 0.f, 0.f, 0.f};
#pragma unroll
            for (int ks = 0; ks < 2; ++ks) { const bf16x8 aq = *(const bf16x8*)(sQK + (16 * mt + r16) * LT + ks * 32 + q4 * 8); a1 = mfma16(aq, bw[ks], a1); a2 = mfma16(aq, bu[ks], a2); }
            const int c = 16 * nt + r16;
#pragma unroll
            for (int e = 0; e < 4; ++e) {
                const int i = 16 * mt + q4 * 4 + e;
                const float qe = bf2f(sQ[i * LK + c]) * sGam[i] - a1[e];
                QEFF[(size_t)i * 128 + c] = (bf16_t)f2bf(qe);
                OPB[(size_t)(n * 64 + i) * 1024 + h * 128 + c] = (bf16_t)f2bf(a2[e]);
            }
        }
    }
    {
        const int mt = wid;
        bf16x8 akd[2], au[2];
#pragma unroll
        for (int ks = 0; ks < 2; ++ks) { akd[ks] = *(const bf16x8*)(sKT + (16 * mt + r16) * LT + ks * 32 + q4 * 8); au[ks] = *(const bf16x8*)(sVT + (16 * mt + r16) * LT + ks * 32 + q4 * 8); }
#pragma unroll
        for (int nt = 0; nt < 8; ++nt) {
            f32x4 a1 = {0.f, 0.f, 0.f, 0.f}, a2 = {0.f, 0.f, 0.f, 0.f};
#pragma unroll
            for (int ks = 0; ks < 2; ++ks) {
                const bf16x8 bw = *(const bf16x8*)(sWT + (16 * nt + r16) * LT + ks * 32 + q4 * 8);
                const bf16x8 bk = *(const bf16x8*)(sKT + (16 * nt + r16) * LT + ks * 32 + q4 * 8);
                a1 = mfma16(akd[ks], bw, a1); a2 = mfma16(au[ks], bk, a2);
            }
#pragma unroll
            for (int e = 0; e < 4; ++e) {
                const int a = 16 * mt + q4 * 4 + e, b = 16 * nt + r16;
                MN[(size_t)a * 128 + b] = (bf16_t)f2bf(-a1[e]);
                BNT[(size_t)a * 128 + b] = (bf16_t)f2bf(a2[e]);
            }
        }
    }
    __syncthreads();
}

__device__ __forceinline__ void dn_sample_unit(const Params& p, int b, int h) {
    const int tid = opaque_tid(), lane = tid & 63, wid = tid >> 6;
    float* sq = (float*)smem; float* sk = sq + 128; float* sv = sq + 256; float* red = sq + 384;
    float* red2 = sq + 400;
    float* red3 = red2 + 512;
    const int row = T + b;
    const bf16_t* PROJ = (const bf16_t*)(p.ws + WS_R2);
    const float* AB = (const float*)(p.ws + WS_AB);
    float val = 0.f;
    if (tid < 384) {
        const int part = tid >> 7, f = tid & 127, col = part * 1024 + h * 128 + f;
        const float* st = p.in[I_SQKV] + (size_t)b * 3 * 3072 + col;
        const float x0 = st[0], x1 = st[3072], x2 = st[2 * 3072], x3 = bf2f(PROJ[(size_t)row * 4096 + col]);
        const float* w = p.in[I_WACONV] + col;
        val = siluf_(w[0] * x0 + w[3072] * x1 + w[2 * 3072] * x2 + w[3 * 3072] * x3);
        float* o = p.out + O_SQS + (size_t)b * 3 * 3072 + col;
        o[0] = x1; o[3072] = x2; o[2 * 3072] = x3;
    }
    { const float s = wave_sum(val * val); if (lane == 0) red[wid] = s; }
    __syncthreads();
    if (tid < 384) {
        const int part = tid >> 7, f = tid & 127;
        if (part == 0) sq[f] = val * rsqrtf(red[0] + red[1] + EPS) * 0.08838834764831845f;
        else if (part == 1) sk[f] = val * rsqrtf(red[2] + red[3] + EPS);
        else sv[f] = val;
    }
    __syncthreads();
    const float av = AB[(size_t)row * 16 + h], bv = AB[(size_t)row * 16 + 8 + h];
    const float eg = __expf(-__expf(p.in[I_ALOG][h]) * softplusf_(av + p.in[I_DTB][h]));
    const float beta = sigmoidf_(bv);
    const int v = tid & 127, kq = tid >> 7;
    const float* S0 = p.in[I_SDELTA] + ((size_t)(b * 8 + h) * 128 + kq * 32) * 128 + v;
    float s[32]; float part = 0.f;
#pragma unroll
    for (int kk = 0; kk < 32; ++kk) { s[kk] = eg * S0[(size_t)kk * 128]; part += sk[kq * 32 + kk] * s[kk]; }
    red2[kq * 128 + v] = part;
    __syncthreads();
    const float u = beta * (sv[v] - (red2[v] + red2[128 + v] + red2[256 + v] + red2[384 + v]));
    float* S1 = p.out + O_SDS + ((size_t)(b * 8 + h) * 128 + kq * 32) * 128 + v;
    float op = 0.f;
#pragma unroll
    for (int kk = 0; kk < 32; ++kk) { s[kk] += sk[kq * 32 + kk] * u; S1[(size_t)kk * 128] = s[kk]; op += sq[kq * 32 + kk] * s[kk]; }
    red3[kq * 128 + v] = op;
    __syncthreads();
    float o = 0.f;
    if (tid < 128) o = red3[v] + red3[128 + v] + red3[256 + v] + red3[384 + v];
    { const float s2 = wave_sum(o * o); if (lane == 0) red[wid] = s2; }
    __syncthreads();
    if (tid < 128) {
        const float rs = rsqrtf((red[0] + red[1]) * (1.0f / 128.0f) + EPS);
        const float z = bf2f(PROJ[(size_t)row * 4096 + 3072 + h * 128 + v]);
        ((bf16_t*)(p.ws + WS_HBA))[(size_t)row * D + h * 128 + v] = (bf16_t)f2bf(o * rs * p.in[I_GAOUT][v] * siluf_(z));
    }
    __syncthreads();
}

__device__ __forceinline__ void p2_deltanet_prep(const Params& p) {
    for (int u = blockIdx.x; u < 2048; u += gridDim.x) d1_unit(p, u >> 3, u & 7);
    for (int u = blockIdx.x; u < SB * 8; u += gridDim.x) dn_sample_unit(p, u >> 3, u & 7);
}

__device__ __forceinline__ void p3_scan(const Params& p) {
    if (blockIdx.x >= 64) return;
    const int tid = opaque_tid(), lane = tid & 63, wid = tid >> 6, r16 = lane & 15, q4 = lane >> 4;
    const int h = blockIdx.x >> 3, vs = blockIdx.x & 7;
    bf16_t* sSt = (bf16_t*)smem;
    float* sO = (float*)(smem + 2 * 16 * LK * 2);
    const bf16_t* QEFF = (const bf16_t*)(p.ws + WS_QEFF); const bf16_t* MN = (const bf16_t*)(p.ws + WS_MN); const bf16_t* BNT = (const bf16_t*)(p.ws + WS_BNT);
    const float* GEND = (const float*)(p.ws + WS_GEND);
    bf16_t* OPB = (bf16_t*)(p.ws + WS_OPB);
    const int tt = wid >> 1, kh = wid & 1;
    for (int i = tid; i < 2 * 16 * LK; i += NTHREADS) sSt[i] = 0;
    __syncthreads();
    f32x4 acc = {0.f, 0.f, 0.f, 0.f};
    bf16x8 mA[4], qA[2]; u32x2 bn; float ge; unsigned short ol[4];
    auto load_step = [&](int n, bf16x8 (&mA_)[4], bf16x8 (&qA_)[2], u32x2& bn_, float& ge_, unsigned short (&ol_)[4]) {
        const size_t ch = (size_t)n * 8 + h;
#pragma unroll
        for (int ks = 0; ks < 4; ++ks) mA_[ks] = *(const bf16x8*)(MN + ch * 16384 + (size_t)(16 * wid + r16) * 128 + ks * 32 + q4 * 8);
#pragma unroll
        for (int ks = 0; ks < 2; ++ks) qA_[ks] = *(const bf16x8*)(QEFF + ch * 8192 + (size_t)(16 * tt + r16) * 128 + kh * 64 + ks * 32 + q4 * 8);
        bn_ = *(const u32x2*)(BNT + ch * 16384 + (size_t)(vs * 16 + r16) * 128 + 16 * wid + q4 * 4);
        ge_ = GEND[ch];
#pragma unroll
        for (int e = 0; e < 4; ++e) ol_[e] = OPB[(size_t)(n * 64 + 16 * tt + q4 * 4 + e) * 1024 + h * 128 + vs * 16 + r16];
    };
    load_step(0, mA, qA, bn, ge, ol);
#pragma unroll 1
    for (int n = 0; n < 256; ++n) {
        bf16x8 mB[4], qB[2]; u32x2 bn2; float ge2; unsigned short ol2[4];
        load_step(n < 255 ? n + 1 : n, mB, qB, bn2, ge2, ol2);
        const int cur = n & 1;
        bf16x8 sb[4];
#pragma unroll
        for (int ks = 0; ks < 4; ++ks) sb[ks] = *(const bf16x8*)(sSt + (cur * 16 + r16) * LK + ks * 32 + q4 * 8);
        f32x4 oacc = {0.f, 0.f, 0.f, 0.f};
        if (kh == 0) { oacc = mfma16(qA[0], sb[0], oacc); oacc = mfma16(qA[1], sb[1], oacc); }
        else { oacc = mfma16(qA[0], sb[2], oacc); oacc = mfma16(qA[1], sb[3], oacc); }
        acc[0] = ge * acc[0] + bflo(bn[0]); acc[1] = ge * acc[1] + bfhi(bn[0]); acc[2] = ge * acc[2] + bflo(bn[1]); acc[3] = ge * acc[3] + bfhi(bn[1]);
#pragma unroll
        for (int ks = 0; ks < 4; ++ks) acc = mfma16(mA[ks], sb[ks], acc);
        { u32x2 w; w[0] = pk2(acc[0], acc[1]); w[1] = pk2(acc[2], acc[3]); *(u32x2*)(sSt + ((cur ^ 1) * 16 + r16) * LK + 16 * wid + q4 * 4) = w; }
        float* so = sO + ((cur * 4 + tt) * 16) * 16;
        if (kh == 1) {
#pragma unroll
            for (int e = 0; e < 4; ++e) so[(q4 * 4 + e) * 16 + r16] = oacc[e];
        }
        __syncthreads();
        if (kh == 0) {
#pragma unroll
            for (int e = 0; e < 4; ++e) {
                const float o = oacc[e] + so[(q4 * 4 + e) * 16 + r16] + bf2f(ol[e]);
                OPB[(size_t)(n * 64 + 16 * tt + q4 * 4 + e) * 1024 + h * 128 + vs * 16 + r16] = (bf16_t)f2bf(o);
            }
        }
#pragma unroll
        for (int ks = 0; ks < 4; ++ks) mA[ks] = mB[ks];
        qA[0] = qB[0]; qA[1] = qB[1]; bn = bn2; ge = ge2;
#pragma unroll
        for (int e = 0; e < 4; ++e) ol[e] = ol2[e];
    }
    float* SD = p.out + O_SDP;
#pragma unroll
    for (int e = 0; e < 4; ++e) SD[(size_t)(h * 128 + 16 * wid + q4 * 4 + e) * 128 + vs * 16 + r16] = acc[e];
}

__device__ __forceinline__ void p4_gate(const Params& p) {
    const int tid = opaque_tid(), lane = tid & 63, wid = tid >> 6;
    const bf16_t* OPB = (const bf16_t*)(p.ws + WS_OPB); const bf16_t* PROJ = (const bf16_t*)(p.ws + WS_R2);
    bf16_t* ON = (bf16_t*)(p.ws + WS_HBA);
    const float* gout = p.in[I_GAOUT];
    for (int r = blockIdx.x * 8 + wid; r < T; r += gridDim.x * 8) {
#pragma unroll
        for (int half = 0; half < 2; ++half) {
            const int c0 = half * 512 + lane * 8;
            const u32x4 ov = *(const u32x4*)(OPB + (size_t)r * 1024 + c0);
            const u32x4 zv = *(const u32x4*)(PROJ + (size_t)r * 4096 + 3072 + c0);
            float o[8], z[8];
#pragma unroll
            for (int e = 0; e < 4; ++e) { o[2 * e] = bflo(ov[e]); o[2 * e + 1] = bfhi(ov[e]); z[2 * e] = bflo(zv[e]); z[2 * e + 1] = bfhi(zv[e]); }
            float ss = 0.f;
#pragma unroll
            for (int e = 0; e < 8; ++e) ss += o[e] * o[e];
            ss += __shfl_xor(ss, 1); ss += __shfl_xor(ss, 2); ss += __shfl_xor(ss, 4); ss += __shfl_xor(ss, 8);
            const float rs = rsqrtf(ss * (1.0f / 128.0f) + EPS);
            const int cg = (lane & 15) * 8;
            float y[8];
#pragma unroll
            for (int e = 0; e < 8; ++e) y[e] = o[e] * rs * gout[cg + e] * siluf_(z[e]);
            u32x4 w; w[0] = pk2(y[0], y[1]); w[1] = pk2(y[2], y[3]); w[2] = pk2(y[4], y[5]); w[3] = pk2(y[6], y[7]);
            *(u32x4*)(ON + (size_t)r * D + c0) = w;
        }
    }
    for (int i = blockIdx.x * NTHREADS + tid; i < 3 * 3072; i += gridDim.x * NTHREADS) {
        const int j = i / 3072, c = i % 3072;
        p.out[O_SQP + i] = bf2f(PROJ[(size_t)(T - 3 + j) * 4096 + c]);
    }
}

__device__ __forceinline__ void p7_convact(const Params& p, int layer) {
    const int tid = opaque_tid();
    const bf16_t* U = (const bf16_t*)(p.ws + WS_U); bf16_t* ACT = (bf16_t*)(p.ws + WS_ACT);
    const float* wc = p.in[I_WFCONV] + (size_t)layer * 3 * DFF2;
    constexpr int NCV = DFF / 8;
    constexpr int STRIP = 16;
    for (int it = blockIdx.x * NTHREADS + tid; it < (T / STRIP) * NCV; it += gridDim.x * NTHREADS) {
        const int strip = it / NCV, cv = it % NCV, c0 = cv * 8, t0 = strip * STRIP;
        float wg[3][8], wu[3][8];
#pragma unroll
        for (int j = 0; j < 3; ++j) {
            const f32x4 a = *(const f32x4*)(wc + j * DFF2 + c0), b = *(const f32x4*)(wc + j * DFF2 + c0 + 4);
            const f32x4 c = *(const f32x4*)(wc + j * DFF2 + DFF + c0), d = *(const f32x4*)(wc + j * DFF2 + DFF + c0 + 4);
#pragma unroll
            for (int e = 0; e < 4; ++e) { wg[j][e] = a[e]; wg[j][4 + e] = b[e]; wu[j][e] = c[e]; wu[j][4 + e] = d[e]; }
        }
        u32x4 g0, g1, u0, u1;
        if (t0 >= 2) {
            g0 = *(const u32x4*)(U + (size_t)(t0 - 2) * DFF2 + c0); u0 = *(const u32x4*)(U + (size_t)(t0 - 2) * DFF2 + DFF + c0);
            g1 = *(const u32x4*)(U + (size_t)(t0 - 1) * DFF2 + c0); u1 = *(const u32x4*)(U + (size_t)(t0 - 1) * DFF2 + DFF + c0);
        } else { g0 = (u32x4){0u, 0u, 0u, 0u}; g1 = g0; u0 = g0; u1 = g0; }
#pragma unroll 4
        for (int i = 0; i < STRIP; ++i) {
            const int t = t0 + i;
            const u32x4 g2 = *(const u32x4*)(U + (size_t)t * DFF2 + c0), u2 = *(const u32x4*)(U + (size_t)t * DFF2 + DFF + c0);
            u32x4 w;
#pragma unroll
            for (int e = 0; e < 4; ++e) {
                const float ga = wg[0][2 * e] * bflo(g0[e]) + wg[1][2 * e] * bflo(g1[e]) + wg[2][2 * e] * bflo(g2[e]);
                const float gb = wg[0][2 * e + 1] * bfhi(g0[e]) + wg[1][2 * e + 1] * bfhi(g1[e]) + wg[2][2 * e + 1] * bfhi(g2[e]);
                const float ua = wu[0][2 * e] * bflo(u0[e]) + wu[1][2 * e] * bflo(u1[e]) + wu[2][2 * e] * bflo(u2[e]);
                const float ub = wu[0][2 * e + 1] * bfhi(u0[e]) + wu[1][2 * e + 1] * bfhi(u1[e]) + wu[2][2 * e + 1] * bfhi(u2[e]);
                w[e] = pk2(siluf_(ga) * ua, siluf_(gb) * ub);
            }
            *(u32x4*)(ACT + (size_t)t * DFF + c0) = w;
            g0 = g1; g1 = g2; u0 = u1; u1 = u2;
        }
    }
    const float* sf = p.in[I_SFFN] + (size_t)layer * SB * 2 * DFF2;
    for (int it = blockIdx.x * NTHREADS + tid; it < SB * DFF; it += gridDim.x * NTHREADS) {
        const int b = it / DFF, c = it % DFF;
        const float g0 = sf[((size_t)b * 2 + 0) * DFF2 + c], g1 = sf[((size_t)b * 2 + 1) * DFF2 + c], g2 = bf2f(U[(size_t)(T + b) * DFF2 + c]);
        const float u0 = sf[((size_t)b * 2 + 0) * DFF2 + DFF + c], u1 = sf[((size_t)b * 2 + 1) * DFF2 + DFF + c], u2 = bf2f(U[(size_t)(T + b) * DFF2 + DFF + c]);
        const float ga = wc[c] * g0 + wc[DFF2 + c] * g1 + wc[2 * DFF2 + c] * g2;
        const float ua = wc[DFF + c] * u0 + wc[DFF2 + DFF + c] * u1 + wc[2 * DFF2 + DFF + c] * u2;
        ACT[(size_t)(T + b) * DFF + c] = (bf16_t)f2bf(siluf_(ga) * ua);
        float* o = p.out + O_SFS + ((size_t)layer * SB + b) * 2 * DFF2;
        o[c] = g1; o[DFF2 + c] = g2; o[DFF + c] = u1; o[DFF2 + DFF + c] = u2;
    }
    for (int i = blockIdx.x * NTHREADS + tid; i < 2 * DFF2; i += gridDim.x * NTHREADS) {
        const int j = i / DFF2, c = i % DFF2;
        p.out[O_SFP + (size_t)layer * 2 * DFF2 + i] = bf2f(U[(size_t)(T - 2 + j) * DFF2 + c]);
    }
}

__device__ __forceinline__ void p11_kvq_post(const Params& p) {
    const int tid = opaque_tid();
    const bf16_t* KVQ = (const bf16_t*)(p.ws + WS_KVQ); bf16_t* KB = (bf16_t*)(p.ws + WS_KB); bf16_t* QB = (bf16_t*)(p.ws + WS_QB);
    const float* ROPE = (const float*)(p.ws + WS_ROPE);
    const int l16 = tid & 15;
    for (int it = (blockIdx.x * NTHREADS + tid) >> 4; it < MV * 24; it += (gridDim.x * NTHREADS) >> 4) {
        const int row = it / 24, j = it % 24;
        const int scol = (j < 12 ? j * 128 : 1536 + (j - 12) * 128) + l16 * 8;
        const u32x4 xv = *(const u32x4*)(KVQ + (size_t)row * 3072 + scol);
        float x[8];
#pragma unroll
        for (int e = 0; e < 4; ++e) { x[2 * e] = bflo(xv[e]); x[2 * e + 1] = bfhi(xv[e]); }
        const bool isv = (j >= 6 && j < 12);
        float ss = 0.f;
#pragma unroll
        for (int e = 0; e < 8; ++e) ss += x[e] * x[e];
        ss += __shfl_xor(ss, 1); ss += __shfl_xor(ss, 2); ss += __shfl_xor(ss, 4); ss += __shfl_xor(ss, 8);
        if (!isv) {
            const float rs = rsqrtf(ss * (1.0f / 128.0f) + EPS);
            const float* gn = (j < 6 ? p.in[I_GK] : p.in[I_GQ]) + l16 * 8;
#pragma unroll
            for (int e = 0; e < 8; ++e) x[e] *= rs * gn[e];
        }
        float part[8];
#pragma unroll
        for (int e = 0; e < 8; ++e) part[e] = __shfl_xor(x[e], 2);
        if (!isv && l16 < 4) {
            const int pos = row < T ? row : T;
            const int i0 = (l16 & 1) * 8;
            const float* cs = ROPE + ((size_t)pos * 16 + i0) * 2;
#pragma unroll
            for (int e = 0; e < 8; ++e) {
                const float c = cs[2 * e], s = cs[2 * e + 1];
                x[e] = (l16 < 2) ? (x[e] * c - part[e] * s) : (x[e] * c + part[e] * s);
            }
        }
        if (!isv) {
            u32x4 w; w[0] = pk2(x[0], x[1]); w[1] = pk2(x[2], x[3]); w[2] = pk2(x[4], x[5]); w[3] = pk2(x[6], x[7]);
            if (j < 6) *(u32x4*)(KB + (size_t)row * 768 + j * 128 + l16 * 8) = w;
            else *(u32x4*)(QB + (size_t)row * 1536 + (j - 12) * 128 + l16 * 8) = w;
        }
        if (j < 12) {
            const int kh = j % 6, kv01 = j / 6, gi = kh >> 1, hh = kh & 1;
            const int W = gi == 0 ? 128 : (gi == 1 ? 512 : 2048);
            float* dst = nullptr;
            if (row < T) {
                if (row >= T - W) {
                    const size_t base = gi == 0 ? O_KV128P : (gi == 1 ? O_KV512P : O_KV2048P);
                    dst = p.out + base + (((size_t)(row - (T - W)) * 2 + kv01) * 2 + hh) * 128 + l16 * 8;
                }
            } else {
                const size_t base = gi == 0 ? O_KV128S : (gi == 1 ? O_KV512S : O_KV2048S);
                dst = p.out + base + (((size_t)(row - T) * 2 + kv01) * 2 + hh) * 128 + l16 * 8;
            }
            if (dst) { *(f32x4*)dst = (f32x4){x[0], x[1], x[2], x[3]}; *(f32x4*)(dst + 4) = (f32x4){x[4], x[5], x[6], x[7]}; }
        }
    }
}

constexpr int AV = 200;
constexpr int AT_SK = 0;
constexpr int AT_SVT = AT_SK + 192 * LK * 2;
static_assert(AT_SVT + 128 * AV * 2 <= LDS_BYTES, "attention LDS");

__device__ __forceinline__ void attn_prompt_unit(const Params& p, int unit) {
    const int tid = opaque_tid(), lane = tid & 63, wid = tid >> 6, r16 = lane & 15, q4 = lane >> 4;
    const int gi = unit >> 9, hh = (unit >> 8) & 1, w = unit & 255;
    const int dil = gi == 0 ? 1 : (gi == 1 ? 4 : 16);
    const int nqb = (T / dil) / 64;
    const int res = w / nqb, qb = w % nqb;
    const bf16_t* KB = (const bf16_t*)(p.ws + WS_KB); const bf16_t* KVQ = (const bf16_t*)(p.ws + WS_KVQ); const bf16_t* QB = (const bf16_t*)(p.ws + WS_QB);
    bf16_t* OG = (bf16_t*)(p.ws + WS_OG) + (size_t)gi * MP * 512; float* LSE = (float*)(p.ws + WS_LSE) + (size_t)gi * MP * 4;
    bf16_t* sKa = (bf16_t*)(smem + AT_SK); bf16_t* sVt = (bf16_t*)(smem + AT_SVT);
    const int kh = gi * 2 + hh;
    const int l0 = qb * 64 - 128;
    {
        const int c8 = (tid & 15) * 8;
#pragma unroll 1
        for (int pass = 0; pass < 6; ++pass) {
            const int kr = pass * 32 + (tid >> 4); const int l = l0 + kr;
            u32x4 kv = (u32x4){0u, 0u, 0u, 0u}, vv = kv;
            if (l >= 0) {
                const size_t t = (size_t)l * dil + res;
                kv = *(const u32x4*)(KB + t * 768 + kh * 128 + c8);
                vv = *(const u32x4*)(KVQ + t * 3072 + 768 + kh * 128 + c8);
            }
            *(u32x4*)(sKa + kr * LK + c8) = kv;
#pragma unroll
            for (int e = 0; e < 4; ++e) { sVt[(c8 + 2 * e) * AV + kr] = (bf16_t)(vv[e] & 0xffffu); sVt[(c8 + 2 * e + 1) * AV + kr] = (bf16_t)(vv[e] >> 16); }
        }
    }
    __syncthreads();
    const int e2 = wid >> 2, qsub = (wid & 3) * 16;
    const int lq = qb * 64 + qsub + r16;
    const size_t tq = (size_t)lq * dil + res;
    bf16x8 qf[4];
#pragma unroll
    for (int ks = 0; ks < 4; ++ks) qf[ks] = *(const bf16x8*)(QB + tq * 1536 + (gi * 4 + hh * 2 + e2) * 128 + ks * 32 + q4 * 8);
    f32x4 sc[12];
#pragma unroll
    for (int kt = 0; kt < 12; ++kt) {
        f32x4 a = {0.f, 0.f, 0.f, 0.f};
#pragma unroll
        for (int ks = 0; ks < 4; ++ks) a = mfma16(*(const bf16x8*)(sKa + (16 * kt + r16) * LK + ks * 32 + q4 * 8), qf[ks], a);
        sc[kt] = a;
    }
    float mx = -3.0e38f;
#pragma unroll
    for (int kt = 0; kt < 12; ++kt)
#pragma unroll
        for (int e = 0; e < 4; ++e) {
            const int lk = l0 + 16 * kt + q4 * 4 + e;
            const bool ok = (lk >= 0) && (lk <= lq) && (lq - lk <= 128);
            const float s = ok ? sc[kt][e] * 0.08838834764831845f : -3.0e38f;
            sc[kt][e] = s; mx = fmaxf(mx, s);
        }
    mx = fmaxf(mx, __shfl_xor(mx, 16)); mx = fmaxf(mx, __shfl_xor(mx, 32));
    float den = 0.f;
#pragma unroll
    for (int kt = 0; kt < 12; ++kt)
#pragma unroll
        for (int e = 0; e < 4; ++e) { const float pe = (sc[kt][e] > -1.0e38f) ? __expf(sc[kt][e] - mx) : 0.f; sc[kt][e] = pe; den += pe; }
    den += __shfl_xor(den, 16); den += __shfl_xor(den, 32);
    f32x4 oa[8];
#pragma unroll
    for (int ct = 0; ct < 8; ++ct) oa[ct] = (f32x4){0.f, 0.f, 0.f, 0.f};
#pragma unroll
    for (int s = 0; s < 6; ++s) {
        u32x4 pw; pw[0] = pk2(sc[2 * s][0], sc[2 * s][1]); pw[1] = pk2(sc[2 * s][2], sc[2 * s][3]); pw[2] = pk2(sc[2 * s + 1][0], sc[2 * s + 1][1]); pw[3] = pk2(sc[2 * s + 1][2], sc[2 * s + 1][3]);
        const bf16x8 pf = __builtin_bit_cast(bf16x8, pw);
#pragma unroll
        for (int ct = 0; ct < 8; ++ct) {
            const u32x2 v0 = *(const u32x2*)(sVt + (16 * ct + r16) * AV + 32 * s + q4 * 4);
            const u32x2 v1 = *(const u32x2*)(sVt + (16 * ct + r16) * AV + 32 * s + 16 + q4 * 4);
            u32x4 vw; vw[0] = v0[0]; vw[1] = v0[1]; vw[2] = v1[0]; vw[3] = v1[1];
            oa[ct] = mfma16(__builtin_bit_cast(bf16x8, vw), pf, oa[ct]);
        }
    }
    const float inv = 1.0f / den;
    bf16_t* orow = OG + tq * 512 + (hh * 2 + e2) * 128;
#pragma unroll
    for (int ct = 0; ct < 8; ++ct) {
        u32x2 wv; wv[0] = pk2(oa[ct][0] * inv, oa[ct][1] * inv); wv[1] = pk2(oa[ct][2] * inv, oa[ct][3] * inv);
        *(u32x2*)(orow + 16 * ct + q4 * 4) = wv;
    }
    if (q4 == 0) LSE[tq * 4 + hh * 2 + e2] = mx + __logf(den);
    __syncthreads();
}

__device__ __forceinline__ void attn_sample_item(const Params& p, int item, int lane) {
    const int e2 = item & 1, hh = (item >> 1) & 1, gi = (item >> 2) % 3, b = item / 12;
    const int dil = gi == 0 ? 1 : (gi == 1 ? 4 : 16), W = gi == 0 ? 128 : (gi == 1 ? 512 : 2048);
    const float* cache = p.in[gi == 0 ? I_C128 : (gi == 1 ? I_C512 : I_C2048)] + (size_t)b * W * 512;
    const bf16_t* KB = (const bf16_t*)(p.ws + WS_KB); const bf16_t* KVQ = (const bf16_t*)(p.ws + WS_KVQ); const bf16_t* QB = (const bf16_t*)(p.ws + WS_QB);
    const int row = T + b, kh = gi * 2 + hh;
    const bf16_t* qp = QB + (size_t)row * 1536 + (gi * 4 + hh * 2 + e2) * 128;
    float s[3];
#pragma unroll
    for (int rd = 0; rd < 3; ++rd) {
        const int m = rd * 64 + lane;
        float acc = 0.f;
        if (m <= 128) {
            if (m == 0) {
                const bf16_t* kp = KB + (size_t)row * 768 + kh * 128;
                for (int c = 0; c < 128; ++c) acc += bf2f(qp[c]) * bf2f(kp[c]);
            } else {
                const float* kp = cache + ((size_t)(W - dil * m) * 2 + 0) * 256 + hh * 128;
                for (int c = 0; c < 128; c += 4) {
                    const f32x4 kv = *(const f32x4*)(kp + c); const u32x2 qv = *(const u32x2*)(qp + c);
                    acc += bflo(qv[0]) * kv[0] + bfhi(qv[0]) * kv[1] + bflo(qv[1]) * kv[2] + bfhi(qv[1]) * kv[3];
                }
            }
            s[rd] = acc * 0.08838834764831845f;
        } else s[rd] = -3.0e38f;
    }
    const float mx = wave_max(fmaxf(fmaxf(s[0], s[1]), s[2]));
    float pe[3]; float den = 0.f;
#pragma unroll
    for (int rd = 0; rd < 3; ++rd) { pe[rd] = (s[rd] > -1.0e38f) ? __expf(s[rd] - mx) : 0.f; den += pe[rd]; }
    den = wave_sum(den);
    float o0 = 0.f, o1 = 0.f;
    for (int m = 0; m <= 128; ++m) {
        const float pm = __shfl(m < 64 ? pe[0] : (m < 128 ? pe[1] : pe[2]), m & 63);
        float v0, v1;
        if (m == 0) { const bf16_t* vp = KVQ + (size_t)row * 3072 + 768 + kh * 128; v0 = bf2f(vp[lane]); v1 = bf2f(vp[lane + 64]); }
        else { const float* vp = cache + ((size_t)(W - dil * m) * 2 + 1) * 256 + hh * 128; v0 = vp[lane]; v1 = vp[lane + 64]; }
        o0 += pm * v0; o1 += pm * v1;
    }
    const float inv = 1.0f / den;
    bf16_t* OG = (bf16_t*)(p.ws + WS_OG) + (size_t)gi * MP * 512; float* LSE = (float*)(p.ws + WS_LSE) + (size_t)gi * MP * 4;
    OG[(size_t)row * 512 + (hh * 2 + e2) * 128 + lane] = (bf16_t)f2bf(o0 * inv);
    OG[(size_t)row * 512 + (hh * 2 + e2) * 128 + lane + 64] = (bf16_t)f2bf(o1 * inv);
    if (lane == 0) LSE[(size_t)row * 4 + hh * 2 + e2] = mx + __logf(den);
}

__device__ __forceinline__ void p12_attention(const Params& p) {
    for (int u = blockIdx.x; u < 1536; u += gridDim.x) attn_prompt_unit(p, u);
    const int wid = opaque_tid() >> 6, lane = opaque_tid() & 63;
    for (int it = blockIdx.x * 8 + wid; it < SB * 12; it += gridDim.x * 8) attn_sample_item(p, it, lane);
}

__device__ __forceinline__ void p13_merge(const Params& p) {
    const int tid = opaque_tid(), lane = tid & 63, wid = tid >> 6;
    const bf16_t* OG = (const bf16_t*)(p.ws + WS_OG); const float* LSE = (const float*)(p.ws + WS_LSE); bf16_t* AM = (bf16_t*)(p.ws + WS_AM);
    for (int r = blockIdx.x * 8 + wid; r < MV; r += gridDim.x * 8) {
        const int slot = lane >> 4;
        const float l0 = LSE[(size_t)r * 4 + slot], l1 = LSE[(size_t)MP * 4 + (size_t)r * 4 + slot], l2 = LSE[(size_t)2 * MP * 4 + (size_t)r * 4 + slot];
        const float mx = fmaxf(l0, fmaxf(l1, l2));
        float w0 = __expf(l0 - mx), w1 = __expf(l1 - mx), w2 = __expf(l2 - mx);
        const float inv = 1.0f / (w0 + w1 + w2); w0 *= inv; w1 *= inv; w2 *= inv;
        const u32x4 a = *(const u32x4*)(OG + (size_t)r * 512 + lane * 8), b = *(const u32x4*)(OG + ((size_t)MP + r) * 512 + lane * 8), c = *(const u32x4*)(OG + ((size_t)2 * MP + r) * 512 + lane * 8);
        u32x4 w;
#pragma unroll
        for (int e = 0; e < 4; ++e) w[e] = pk2(w0 * bflo(a[e]) + w1 * bflo(b[e]) + w2 * bflo(c[e]), w0 * bfhi(a[e]) + w1 * bfhi(b[e]) + w2 * bfhi(c[e]));
        *(u32x4*)(AM + (size_t)r * 512 + lane * 8) = w;
    }
}

constexpr int NPHASES = 19;
__global__ void __launch_bounds__(NTHREADS) yoco_fwd(Params p) {
    cg::grid_group grid = cg::this_grid();
    bf16_t* HBA = (bf16_t*)(p.ws + WS_HBA); bf16_t* HBB = (bf16_t*)(p.ws + WS_HBB);
    float* SSQA = (float*)(p.ws + WS_SSQA); float* SSQB = (float*)(p.ws + WS_SSQB);
    float* yp = p.out + O_YP; float* ys = p.out + O_YS;
#define PHASE_BEGIN(n) if (p.ph_lo <= (n) && (n) < p.ph_hi) {
#define PHASE_END(n) if ((n) + 1 < p.ph_hi) grid.sync(); }
    PHASE_BEGIN(0) p0_prologue(p); PHASE_END(0)
    PHASE_BEGIN(1) { EpiScale E{(bf16_t*)(p.ws + WS_R2), 4096, SSQA}; run_gemm(HBA, (const bf16_t*)(p.ws + WS_WIN), 4096, 1024, E); } PHASE_END(1)
    PHASE_BEGIN(2) p2_deltanet_prep(p); PHASE_END(2)
    PHASE_BEGIN(3) p3_scan(p); PHASE_END(3)
    PHASE_BEGIN(4) p4_gate(p); PHASE_END(4)
    PHASE_BEGIN(5) { EpiResid E{p.in[I_XP], p.in[I_XS], yp, ys, HBB, SSQB, nullptr, nullptr, 0}; run_gemm(HBA, (const bf16_t*)(p.ws + WS_WOUT), 1024, 1024, E); } PHASE_END(5)
#pragma unroll 1
    for (int l = 0; l < 2; ++l) {
        const int pb = l == 0 ? 6 : 15;
        bf16_t* hb0 = l == 0 ? HBB : HBA; bf16_t* hb1 = l == 0 ? HBA : HBB; float* sq0 = l == 0 ? SSQB : SSQA; float* sq1 = l == 0 ? SSQA : SSQB;
        PHASE_BEGIN(pb) { EpiScale E{(bf16_t*)(p.ws + WS_U), DFF2, sq0}; run_gemm(hb0, (const bf16_t*)(p.ws + WS_WUP) + (size_t)l * DFF2 * 1024, DFF2, 1024, E); } PHASE_END(pb)
        PHASE_BEGIN(pb + 1) p7_convact(p, l); PHASE_END(pb + 1)
        PHASE_BEGIN(pb + 2) {
            EpiResid E{yp, ys, yp, ys, hb1, sq1, nullptr, nullptr, 0};
            run_gemm((const bf16_t*)(p.ws + WS_ACT), (const bf16_t*)(p.ws + WS_WDN) + (size_t)l * 1024 * DFF, 1024, DFF, E);
            EpiScale E2{(bf16_t*)(p.ws + WS_PP), 1024, nullptr};
            run_gemm((const bf16_t*)(p.ws + WS_PB) + (size_t)l * MP * PLE, (const bf16_t*)(p.ws + WS_WPP) + (size_t)l * 1024 * PLE, 1024, PLE, E2);
        } PHASE_END(pb + 2)
        PHASE_BEGIN(pb + 3) { EpiResid E{yp, ys, yp, ys, hb0, sq0, sq1, (const bf16_t*)(p.ws + WS_PP), 1}; run_gemm(hb1, (const bf16_t*)(p.ws + WS_WGATE) + (size_t)l * 1024 * 1024, 1024, 1024, E); } PHASE_END(pb + 3)
        if (l == 0) {
            PHASE_BEGIN(10) { EpiScale E{(bf16_t*)(p.ws + WS_KVQ), 3072, SSQB}; run_gemm(HBB, (const bf16_t*)(p.ws + WS_WKVQ), 3072, 1024, E); } PHASE_END(10)
            PHASE_BEGIN(11) p11_kvq_post(p); PHASE_END(11)
            PHASE_BEGIN(12) p12_attention(p); PHASE_END(12)
            PHASE_BEGIN(13) p13_merge(p); PHASE_END(13)
            PHASE_BEGIN(14) { EpiResid E{yp, ys, yp, ys, HBA, SSQA, nullptr, nullptr, 0}; run_gemm((const bf16_t*)(p.ws + WS_AM), (const bf16_t*)(p.ws + WS_WO), 1024, 512, E); } PHASE_END(14)
        }
    }
}

#ifndef N_LAUNCH_MODE
#define N_LAUNCH_MODE 0
#endif
extern "C" void kernel_launch(void* const* d_in, const int* in_sizes, int n_in, void* d_out, int out_size, void* d_ws, size_t ws_size, hipStream_t stream) {
    static int grid = 0;
    if (grid == 0) {
        if (n_in != 30 || (size_t)out_size != O_END || ws_size < WS_END) { fprintf(stderr, "kernel_launch: unexpected sizes n_in %d out %d ws %zu (need %zu)\n", n_in, out_size, ws_size, (size_t)WS_END); grid = -1; return; }
        int dev = 0, cus = 0, per_cu = 0;
        hipGetDevice(&dev); hipDeviceGetAttribute(&cus, hipDeviceAttributeMultiprocessorCount, dev);
        if (hipFuncSetAttribute((const void*)yoco_fwd, hipFuncAttributeMaxDynamicSharedMemorySize, LDS_BYTES) != hipSuccess) { fprintf(stderr, "hipFuncSetAttribute failed\n"); grid = -1; return; }
        if (hipOccupancyMaxActiveBlocksPerMultiprocessor(&per_cu, (const void*)yoco_fwd, NTHREADS, LDS_BYTES) != hipSuccess || per_cu < 1) { fprintf(stderr, "occupancy query failed (%d)\n", per_cu); (void)hipGetLastError(); per_cu = 1; }
        grid = cus * 1;
        if (grid > cus * per_cu) grid = cus * per_cu;
    }
    if (grid < 0) return;
    Params p{};
    for (int i = 0; i < 30; ++i) p.in[i] = (const float*)d_in[i];
    p.out = (float*)d_out; p.ws = (unsigned char*)d_ws;
    for (int i = 0; i < 16; ++i) p.invf[i] = std::pow(500000.0, -(double)i / 16.0);
#if N_LAUNCH_MODE == 0
    for (int ph = 0; ph < NPHASES; ++ph) {
        p.ph_lo = ph; p.ph_hi = ph + 1;
        void* args[] = {&p};
        hipError_t e = hipLaunchCooperativeKernel((const void*)yoco_fwd, dim3(grid), dim3(NTHREADS), args, LDS_BYTES, stream);
        if (e != hipSuccess) { fprintf(stderr, "launch failed: %s\n", hipGetErrorString(e)); break; }
    }
#else
    p.ph_lo = 0; p.ph_hi = NPHASES;
    void* args[] = {&p};
    hipError_t e = hipLaunchCooperativeKernel((const void*)yoco_fwd, dim3(grid), dim3(NTHREADS), args, LDS_BYTES, stream);
    if (e != hipSuccess) fprintf(stderr, "launch failed: %s\n", hipGetErrorString(e));
#endif
}
```
